# Optimizing an MI355X kernel written in HIP

```python
import jax
import jax.numpy as jnp
from jax import lax
import numpy as np

D_MODEL = 1024
BATCH = 16
SEQ = 2048
DEPTH = 1

MIX_WIDTH = D_MODEL
GMLP_CHUNK = 128
GMLP_GROUPS = 8
GMLP_GROUP_DIM = MIX_WIDTH // GMLP_GROUPS
HGRN_HEADS = 8
HGRN_HEAD_DIM = MIX_WIDTH // HGRN_HEADS
HGRN_CHUNK = 64
N_IN_SLICES = 8
N_GROUPS = 4
EXPERTS_PER_GROUP = 4
N_EXPERTS = N_GROUPS * EXPERTS_PER_GROUP
EXPERT_FF = D_MODEL // 2
TOP_K_IN_GROUP = 2
RMS_EPS = 1e-6
LN_EPS = 1e-5

kernel_name = "hybrid_gmlp_hgrn2_hmoe_block"


def _rmsnorm(x, g):
    xf = x.astype(jnp.float32)
    y = xf * lax.rsqrt(jnp.mean(xf * xf, axis=-1, keepdims=True) + RMS_EPS)
    return (y * g.astype(jnp.float32)).astype(x.dtype)


def _layernorm(x, g, b):
    xf = x.astype(jnp.float32)
    mu = jnp.mean(xf, axis=-1, keepdims=True)
    var = jnp.mean(jnp.square(xf - mu), axis=-1, keepdims=True)
    y = (xf - mu) * lax.rsqrt(var + LN_EPS)
    return (y * g.astype(jnp.float32) + b.astype(jnp.float32)).astype(x.dtype)


def _hgrn2_chunk_scan(q, k, v, log_f):
    b_, s_, h_, kd = q.shape
    vd = v.shape[-1]
    n = s_ // HGRN_CHUNK

    def to_chunks(t):
        return t.astype(jnp.float32).reshape(b_, n, HGRN_CHUNK, h_, t.shape[-1]).transpose(1, 0, 3, 2, 4)

    qc, kc, vc, fc = to_chunks(q), to_chunks(k), to_chunks(v), to_chunks(log_f)
    causal = jnp.tril(jnp.ones((HGRN_CHUNK, HGRN_CHUNK), dtype=bool))[:, :, None]

    def step(state, inp):
        q_, k_, v_, lf = inp
        bcum = jnp.cumsum(lf, axis=2)
        diff = bcum[:, :, :, None, :] - bcum[:, :, None, :, :]
        decay = jnp.exp(jnp.where(causal, diff, -jnp.inf))
        scores = jnp.einsum('bhtsk,bhsk->bhts', q_[:, :, :, None, :] * decay, k_)
        o = (jnp.einsum('bhts,bhsv->bhtv', scores, v_)
             + jnp.einsum('bhtk,bhkv->bhtv', q_ * jnp.exp(bcum), state))
        b_last = bcum[:, :, -1:, :]
        state = (jnp.exp(b_last[:, :, 0, :])[..., None] * state
                 + jnp.einsum('bhsk,bhsv->bhkv', k_ * jnp.exp(b_last - bcum), v_))
        return state, o

    s0 = jnp.zeros((b_, h_, kd, vd), jnp.float32)
    _, o = lax.scan(step, s0, (qc, kc, vc, fc))
    return o.transpose(1, 0, 3, 2, 4).reshape(b_, s_, h_, vd)


def _token_mixer(h, w_in, ln_v_g, ln_v_b, w_spatial, b_spatial, lb, g_hgrn, w_out):
    b_, s_, _ = h.shape
    proj = h @ w_in
    u, v, q, f_raw, i, og, gate_a, gate_b = jnp.split(proj, N_IN_SLICES, axis=-1)

    u = jax.nn.gelu(u)
    v = _layernorm(jax.nn.gelu(v), ln_v_g, ln_v_b)
    n = s_ // GMLP_CHUNK
    vc = v.reshape(b_, n, GMLP_CHUNK, GMLP_GROUPS, GMLP_GROUP_DIM)
    w_causal = w_spatial * jnp.tril(jnp.ones((GMLP_CHUNK, GMLP_CHUNK), w_spatial.dtype))
    zv = jnp.einsum('gts,bnsgc->bntgc', w_causal, vc) + b_spatial.T[:, :, None]
    y_a = u * zv.reshape(b_, s_, MIX_WIDTH)

    hs = (b_, s_, HGRN_HEADS, HGRN_HEAD_DIM)
    qh = jax.nn.silu(q).reshape(hs)
    f = lb + (1.0 - lb) * jax.nn.sigmoid(f_raw.astype(jnp.float32))
    log_f = jnp.log(f).reshape(hs)
    kh = (1.0 - f).reshape(hs)
    o = _hgrn2_chunk_scan(qh, kh, i.reshape(hs), log_f)
    o = _rmsnorm(o, g_hgrn.reshape(HGRN_HEADS, HGRN_HEAD_DIM))
    y_b = o.reshape(b_, s_, MIX_WIDTH).astype(h.dtype) * jax.nn.silu(og)

    y = jax.nn.sigmoid(gate_a) * y_a + jax.nn.sigmoid(gate_b) * y_b
    return y @ w_out


def _hier_moe(h, w_rg, b_rg, w_re, b_re, w1, w3, w2):
    b_, s_, _ = h.shape
    p_group = jax.nn.softmax((h @ w_rg + b_rg).astype(jnp.float32), axis=-1)
    p_top, g_idx = lax.top_k(p_group, 1)
    e_logits = (h @ w_re + b_re).astype(jnp.float32).reshape(b_, s_, N_GROUPS, EXPERTS_PER_GROUP)
    sel = jax.nn.one_hot(g_idx[..., 0], N_GROUPS, dtype=jnp.float32)
    e_logits = jnp.einsum('bsge,bsg->bse', e_logits, sel)
    p_exp = jax.nn.softmax(e_logits, axis=-1)
    top_p, top_i = lax.top_k(p_exp, TOP_K_IN_GROUP)
    w = p_top * top_p / jnp.sum(top_p, axis=-1, keepdims=True)
    expert_id = g_idx * EXPERTS_PER_GROUP + top_i
    combine = jnp.sum(w[..., None] * jax.nn.one_hot(expert_id, N_EXPERTS, dtype=jnp.float32), axis=-2)
    combine = combine.astype(h.dtype)
    y = jnp.zeros_like(h)
    for e in range(N_EXPERTS):
        a = jax.nn.silu(h @ w1[e]) * (h @ w3[e])
        y = y + combine[..., e:e + 1] * (a @ w2[e])
    return y


def setup_inputs(seed: int = 0) -> dict:
    key = jax.random.key(seed)
    ks = jax.random.split(key, 23)

    def nrm(k, shape, scale):
        return jax.random.normal(k, shape, jnp.float32) * scale

    d, wd, c_ = D_MODEL, MIX_WIDTH, GMLP_CHUNK
    return {
        "x": nrm(ks[0], (BATCH, SEQ, d), 1.0),
        "c": nrm(ks[1], (BATCH, d), 1.0),
        "w_ada": nrm(ks[2], (DEPTH, d, 6 * d), 0.5 * d ** -0.5),
        "b_ada": nrm(ks[3], (DEPTH, 6 * d), 0.01),
        "g_pre_mix": 1.0 + nrm(ks[4], (DEPTH, d), 0.05),
        "g_post_mix": 1.0 + nrm(ks[5], (DEPTH, d), 0.05),
        "w_in": nrm(ks[6], (DEPTH, d, N_IN_SLICES * wd), d ** -0.5),
        "ln_v_g": 1.0 + nrm(ks[7], (DEPTH, wd), 0.05),
        "ln_v_b": nrm(ks[8], (DEPTH, wd), 0.02),
        "w_spatial": nrm(ks[9], (DEPTH, GMLP_GROUPS, c_, c_), 0.5 * c_ ** -0.5),
        "b_spatial": 1.0 + nrm(ks[10], (DEPTH, GMLP_GROUPS, c_), 0.05),
        "lb_logits": nrm(ks[11], (DEPTH + 1, wd), 0.1),
        "g_hgrn_norm": 1.0 + nrm(ks[12], (DEPTH, wd), 0.05),
        "w_out": nrm(ks[13], (DEPTH, wd, d), wd ** -0.5),
        "g_pre_ffn": 1.0 + nrm(ks[14], (DEPTH, d), 0.05),
        "g_post_ffn": 1.0 + nrm(ks[15], (DEPTH, d), 0.05),
        "w_router_group": nrm(ks[16], (DEPTH, d, N_GROUPS), d ** -0.5),
        "b_router_group": nrm(ks[17], (DEPTH, N_GROUPS), 0.01),
        "w_router_expert": nrm(ks[18], (DEPTH, d, N_EXPERTS), d ** -0.5),
        "b_router_expert": nrm(ks[19], (DEPTH, N_EXPERTS), 0.01),
        "w1": nrm(ks[20], (DEPTH, N_EXPERTS, d, EXPERT_FF), d ** -0.5),
        "w3": nrm(ks[21], (DEPTH, N_EXPERTS, d, EXPERT_FF), d ** -0.5),
        "w2": nrm(ks[22], (DEPTH, N_EXPERTS, EXPERT_FF, d), EXPERT_FF ** -0.5),
    }


def reference(x, c, w_ada, b_ada, g_pre_mix, g_post_mix, w_in, ln_v_g, ln_v_b,
              w_spatial, b_spatial, lb_logits, g_hgrn_norm, w_out, g_pre_ffn,
              g_post_ffn, w_router_group, b_router_group, w_router_expert,
              b_router_expert, w1, w3, w2):
    lb_all = jnp.cumsum(jax.nn.softmax(lb_logits.astype(jnp.float32), axis=0), axis=0)
    for layer in range(DEPTH):
        ada = jax.nn.silu(c) @ w_ada[layer] + b_ada[layer]
        sh1, sc1, gt1, sh2, sc2, gt2 = jnp.split(ada[:, None, :], 6, axis=-1)

        h = _rmsnorm(x, g_pre_mix[layer]) * (1.0 + sc1) + sh1
        y = _token_mixer(h, w_in[layer], ln_v_g[layer], ln_v_b[layer], w_spatial[layer],
                         b_spatial[layer], lb_all[layer], g_hgrn_norm[layer], w_out[layer])
        x = x + gt1 * _rmsnorm(y, g_post_mix[layer])

        h = _rmsnorm(x, g_pre_ffn[layer]) * (1.0 + sc2) + sh2
        y = _hier_moe(h, w_router_group[layer], b_router_group[layer], w_router_expert[layer],
                      b_router_expert[layer], w1[layer], w3[layer], w2[layer])
        x = x + gt2 * _rmsnorm(y, g_post_ffn[layer])
    return x
```

```cpp
#include <hip/hip_runtime.h>
#include <cstdio>
#include <cstdint>

#define GAS __attribute__((address_space(1)))
#define LAS __attribute__((address_space(3)))
typedef unsigned short bf16;
typedef unsigned v4u __attribute__((ext_vector_type(4)));
typedef unsigned v2u __attribute__((ext_vector_type(2)));
typedef float f32x4 __attribute__((ext_vector_type(4)));
typedef float f32x2 __attribute__((ext_vector_type(2)));
typedef short bf16x8 __attribute__((ext_vector_type(8)));
typedef GAS unsigned gu32;

constexpr int D = 1024, BATCH = 16, SEQ = 2048, T = BATCH * SEQ, NIN = 8 * D, NE = 16, FF = 512;
constexpr int NPMAX = 69632;
constexpr float RMS_EPS = 1e-6f, LN_EPS = 1e-5f;
constexpr int NWAVES = 8, NTHREADS = 512;

constexpr size_t MiB = 1u << 20;
constexpr size_t WS_CTL = 0, CTL_ZERO_BYTES = 1 * MiB;
constexpr size_t WS_ADA = 1 * MiB;
constexpr size_t WS_LBV = 2 * MiB;
constexpr size_t WS_CNT = 2 * MiB + 64 * 1024;
constexpr size_t WS_OFFS = 2 * MiB + 96 * 1024;
constexpr size_t WS_EID = 2 * MiB + 128 * 1024;
constexpr size_t WS_EW = WS_EID + 256 * 1024;
constexpr size_t WS_RANK = WS_EW + 256 * 1024;
constexpr size_t WS_POS = WS_RANK + 256 * 1024;
constexpr size_t WS_IDX = 3 * MiB + 256 * 1024;
constexpr size_t WS_VSTAT = 4 * MiB;
constexpr size_t WS_IDXREL = 4 * MiB;
constexpr int CW_QUEUE = 61440;
constexpr int CW_PANEL = 32768;
constexpr int CW_TOT = 2048;
constexpr size_t WS_WIN = 12 * MiB;
constexpr size_t WS_WOUT = 28 * MiB;
constexpr size_t WS_H = 32 * MiB;
constexpr size_t WS_GAU = 96 * MiB, WS_GBOG = 160 * MiB, WS_GV = 224 * MiB, WS_QS = 288 * MiB, WS_G = 352 * MiB, WS_IV = 416 * MiB;
constexpr size_t WS_Y2 = 96 * MiB;
constexpr size_t WS_X1 = 336 * MiB;
constexpr size_t WS_H2 = 400 * MiB;
constexpr size_t WS_W13 = 480 * MiB;
constexpr size_t WS_W2 = 12 * MiB;
constexpr size_t WS_H2P = 336 * MiB;
constexpr size_t WS_ACT = 96 * MiB;
constexpr size_t WS_OUTP = 164 * MiB;
constexpr size_t WS_END = 512 * MiB;

constexpr int LDS_BYTES = 155648;
constexpr int MISC_OFF = 131072 + 320;

#define RLX_AGENT __ATOMIC_RELAXED, __HIP_MEMORY_SCOPE_AGENT
#define LDS_WAIT() asm volatile("s_waitcnt lgkmcnt(0)" ::: "memory")
__device__ __forceinline__ unsigned f2bf(float f) { unsigned u = __builtin_bit_cast(unsigned, f); return (u + 0x7fffu + ((u >> 16) & 1u)) >> 16; }
typedef __bf16 bf16x2_hw __attribute__((ext_vector_type(2)));
typedef float f32x2_hw __attribute__((ext_vector_type(2)));
__device__ __forceinline__ unsigned pk2(float lo, float hi) { const f32x2_hw v = {lo, hi}; return __builtin_bit_cast(unsigned, __builtin_convertvector(v, bf16x2_hw)); }
__device__ __forceinline__ float bf2f(unsigned b) { return __builtin_bit_cast(float, b << 16); }
__device__ __forceinline__ float sigmoid_f(float z) { return 1.0f / (1.0f + __expf(-z)); }
__device__ __forceinline__ float gelu_f(float x) { return x * sigmoid_f(1.5957691216057308f * (x + 0.044715f * x * x * x)); }
__device__ __forceinline__ float silu_f(float x) { return x * sigmoid_f(x); }
__device__ __forceinline__ float wave_sum(float v) {
#pragma unroll
    for (int o = 1; o < 64; o <<= 1) v += __shfl_xor(v, o);
    return v;
}

namespace pg8 {
#define PG8_LAS __attribute__((address_space(3)))
typedef unsigned short bf16_t;
typedef short bf16x8 __attribute__((ext_vector_type(8)));
typedef float f32x4 __attribute__((ext_vector_type(4)));
typedef unsigned u32x4 __attribute__((ext_vector_type(4)));
constexpr int BM = 256, BK = 64, HALF = 128, HTB = HALF * BK * 2  , STAGE_BYTES = 8 * HTB, NXCD = 8, WGM = 8;

__host__ __device__ __forceinline__ int lds_byte(int r, int c) { const int st = (r >> 4) * 2 + (c >> 5), rr = r & 15, cc = c & 31, ob = rr * 64 + cc * 2; return st * 1024 + (ob ^ (((ob >> 9) & 1) << 5)); }
__host__ __device__ __forceinline__ void stage_rc(int b, int& R, int& C) { const int st = b / 1024, sb = b % 1024, swz = sb ^ (((sb >> 9) & 1) << 5); R = (st >> 1) * 16 + swz / 64; C = (st & 1) * 32 + (swz % 64) / 2; }
__host__ __device__ __forceinline__ int perm32(int rho) { const int n = rho >> 4, i = rho & 15; return 8 * (i >> 2) + 4 * n + (i & 3); }

struct Unit { int pm, pn, pnb; };
struct Gemm { const bf16_t* A; const bf16_t* Bt; int M, N, K; const PG8_LAS int* sidx; };

struct StaticOrder {
    int nM, nN, nwg, G, c;
    __host__ __device__ void init(int M, int N, int G_, int c_) { nM = M / BM; nN = N / BM; nwg = nM * nN; G = G_; c = c_; }
    __host__ __device__ bool next(int i, Unit& u) const {
        const long L = (long)i * G + c; if (L >= nwg) return false;
        int wgid = (int)L; { const int q = nwg / NXCD, r = nwg % NXCD, xcd = wgid % NXCD, off = wgid / NXCD; wgid = (xcd < r ? xcd * (q + 1) : r * (q + 1) + (xcd - r) * q) + off; }
        const int nig = WGM * nN, gid = wgid / nig, fm = gid * WGM, gsz = (nM - fm) < WGM ? (nM - fm) : WGM;
        u.pm = fm + ((wgid % nig) % gsz); u.pn = (wgid % nig) / gsz; u.pnb = u.pn; return true;
    }
    __device__ __forceinline__ void a_ready(const Unit&) const {}
    __device__ __forceinline__ void done(const Unit&) const {}
    __device__ __forceinline__ void done_deferred(const Unit&) const {}
};

typedef float f32x2 __attribute__((ext_vector_type(2)));

typedef __bf16 bf16x2_t __attribute__((ext_vector_type(2)));
__device__ __forceinline__ unsigned cvt_pk_bf16(float lo, float hi) { const f32x2 v = {lo, hi}; const bf16x2_t b = __builtin_convertvector(v, bf16x2_t); return __builtin_bit_cast(unsigned, b); }
__device__ __forceinline__ float ex2(float x) { return __builtin_amdgcn_exp2f(x); }
__device__ __forceinline__ float rcp(float x) { return __builtin_amdgcn_rcpf(x); }
constexpr float L2E = 1.4426950408889634f, GK = 1.5957691216057308f * 1.4426950408889634f;
__device__ __forceinline__ float gelu_arg(float x) { return -GK * (x + 0.044715f * x * x * x); }
__device__ __forceinline__ u32x4 pack8(const float (&o)[8]) { u32x4 w; w.x = cvt_pk_bf16(o[0], o[1]); w.y = cvt_pk_bf16(o[2], o[3]); w.z = cvt_pk_bf16(o[4], o[5]); w.w = cvt_pk_bf16(o[6], o[7]); return w; }

struct EpiInproj {
    static constexpr bool PERM = true, AFTER_DRAIN = false;
    bf16_t *GAU, *GBOG, *GV, *QS, *G, *IV; float* VSTAT; const float* lbv;
    __device__ __forceinline__ void operator()(const f32x4 (&acc)[2][2][4][2], const Unit& u, int wr, int wc, int fr, int fq) const {
        const int j = u.pn >> 2, type = u.pn & 3, row0 = u.pm * BM + wr * 64 + fr, col0 = 128 * j + wc * 32 + 8 * fq;
        float lb[8];
        if (type == 3) { const f32x4 l0 = *(const f32x4*)(lbv + col0), l1 = *(const f32x4*)(lbv + col0 + 4); lb[0] = l0[0]; lb[1] = l0[1]; lb[2] = l0[2]; lb[3] = l0[3]; lb[4] = l1[0]; lb[5] = l1[1]; lb[6] = l1[2]; lb[7] = l1[3]; }
        else {
#pragma unroll
            for (int i = 0; i < 8; ++i) lb[i] = 0.f; }
#pragma unroll
        for (int ai = 0; ai < 2; ++ai)
#pragma unroll
            for (int m = 0; m < 4; ++m) {
                const int row = row0 + ai * HALF + m * 16; const size_t off = ((size_t)(row >> 4) * 32 + (col0 >> 5)) * 512 + (row & 15) * 32 + (col0 & 31);
                float a[8], b[8], o[8];
#pragma unroll
                for (int i = 0; i < 4; ++i) { a[i] = acc[ai][0][m][0][i]; a[4 + i] = acc[ai][0][m][1][i]; b[i] = acc[ai][1][m][0][i]; b[4 + i] = acc[ai][1][m][1][i]; }
                if (type == 0) {
#pragma unroll
                    for (int i = 0; i < 8; ++i) o[i] = a[i] * rcp((1.0f + ex2(gelu_arg(a[i]))) * (1.0f + ex2(-L2E * b[i])));
                    *(u32x4*)(GAU + off) = pack8(o);
                } else if (type == 1) {
#pragma unroll
                    for (int i = 0; i < 8; ++i) o[i] = a[i] * rcp((1.0f + ex2(-L2E * a[i])) * (1.0f + ex2(-L2E * b[i])));
                    __builtin_nontemporal_store(pack8(o), (u32x4*)(GBOG + off));
                } else if (type == 2) {
                    float s = 0.f, ss = 0.f;
#pragma unroll
                    for (int i = 0; i < 8; ++i) { o[i] = a[i] * rcp(1.0f + ex2(gelu_arg(a[i]))); s += o[i]; ss += o[i] * o[i]; }
                    *(u32x4*)(GV + off) = pack8(o);
#pragma unroll
                    for (int i = 0; i < 8; ++i) o[i] = b[i] * rcp(1.0f + ex2(-L2E * b[i]));
                    __builtin_nontemporal_store(pack8(o), (u32x4*)(QS + off));
                    s += __shfl_xor(s, 16); ss += __shfl_xor(ss, 16); s += __shfl_xor(s, 32); ss += __shfl_xor(ss, 32);
                    if (fq == 0) *(f32x2*)(VSTAT + ((size_t)row * 32 + 4 * j + wc) * 2) = (f32x2){s, ss};
                } else {
#pragma unroll
                    for (int i = 0; i < 8; ++i) { const float sg = rcp(1.0f + ex2(-L2E * a[i])); o[i] = 0.6931471805599453f * __builtin_amdgcn_logf(lb[i] + (1.0f - lb[i]) * sg); }
                    __builtin_nontemporal_store(pack8(o), (u32x4*)(G + off));
                    __builtin_nontemporal_store(pack8(b), (u32x4*)(IV + off));
                }
            }
    }
};
struct EpiF32 {
    static constexpr bool PERM = false, AFTER_DRAIN = false;
    float* C; int ldc;
    __device__ __forceinline__ void operator()(const f32x4 (&acc)[2][2][4][2], const Unit& u, int wr, int wc, int fr, int fq) const {
        const int row0 = u.pm * BM + wr * 64 + fr, col0 = u.pn * BM + wc * 32 + 4 * fq;
#pragma unroll
        for (int ai = 0; ai < 2; ++ai)
#pragma unroll
            for (int m = 0; m < 4; ++m) { float* rowp = C + (size_t)(row0 + ai * HALF + m * 16) * ldc + col0;
#pragma unroll
                for (int bj = 0; bj < 2; ++bj)
#pragma unroll
                    for (int n = 0; n < 2; ++n) *(f32x4*)(rowp + bj * HALF + n * 16) = acc[ai][bj][m][n]; }
    }
};
struct EpiMoe1 {
    static constexpr bool PERM = true, AFTER_DRAIN = false;
    bf16_t* ACT; int act_bytes;
    __device__ __forceinline__ void operator()(const f32x4 (&acc)[2][2][4][2], const Unit& u, int wr, int wc, int fr, int fq) const {
        const int row0 = u.pm * BM + wr * 64 + fr, col0 = 128 * u.pn + wc * 32 + 8 * fq;
        const __amdgpu_buffer_rsrc_t rs = __builtin_amdgcn_make_buffer_rsrc(ACT, 0, act_bytes, 0x00020000);
#pragma unroll
        for (int ai = 0; ai < 2; ++ai)
#pragma unroll
            for (int m = 0; m < 4; ++m) { float o[8];
#pragma unroll
                for (int i = 0; i < 4; ++i) { const float a0 = acc[ai][0][m][0][i], a1 = acc[ai][0][m][1][i];
                    o[i] = a0 * acc[ai][1][m][0][i] * rcp(1.0f + ex2(-L2E * a0)); o[4 + i] = a1 * acc[ai][1][m][1][i] * rcp(1.0f + ex2(-L2E * a1)); }
                __builtin_amdgcn_raw_buffer_store_b128(pack8(o), rs, (unsigned)(((row0 + ai * HALF + m * 16) * 512 + col0) * 2), 0,   16); }
    }
};
struct EpiBf16 {
    static constexpr bool PERM = true, AFTER_DRAIN = false;
    bf16_t* O; int ldc;
    __device__ __forceinline__ void operator()(const f32x4 (&acc)[2][2][4][2], const Unit& u, int wr, int wc, int fr, int fq) const {
        const int row0 = u.pm * BM + wr * 64 + fr, col0 = u.pn * BM + wc * 32 + 8 * fq;
#pragma unroll
        for (int ai = 0; ai < 2; ++ai)
#pragma unroll
            for (int m = 0; m < 4; ++m) { bf16_t* rowp = O + (size_t)(row0 + ai * HALF + m * 16) * ldc + col0;
#pragma unroll
                for (int bj = 0; bj < 2; ++bj) { const f32x4 v0 = acc[ai][bj][m][0], v1 = acc[ai][bj][m][1]; u32x4 w;
                    w.x = cvt_pk_bf16(v0[0], v0[1]); w.y = cvt_pk_bf16(v0[2], v0[3]); w.z = cvt_pk_bf16(v1[0], v1[1]); w.w = cvt_pk_bf16(v1[2], v1[3]);
                    *(u32x4*)(rowp + bj * HALF) = w; } }
    }
};
typedef int pg8_i4 __attribute__((ext_vector_type(4)));
template <class Base> struct TableOrder : Base {
    const PG8_LAS pg8_i4* tab; int n;
    __device__ __forceinline__ bool next(int i, Unit& u) const { if (i >= n) return false; const pg8_i4 v = tab[i]; u.pm = v.x; u.pn = v.y; u.pnb = v.z; return true; }
    __device__ __forceinline__ void fill(PG8_LAS pg8_i4* t, int cap) { if ((int)threadIdx.x < cap) { Unit u; const bool ok = Base::next((int)threadIdx.x, u); t[threadIdx.x] = ok ? (pg8_i4){u.pm, u.pn, u.pnb, 1} : (pg8_i4){0, 0, 0, 0}; } }
    __device__ __forceinline__ void finish(const PG8_LAS pg8_i4* t, int cap) { tab = t; int k = 0; for (int i = 0; i < cap; ++i) k += t[i].w; n = k; }
};
struct GroupedOrder {
    const PG8_LAS int* offs; int nN, nwg, G, c;
    __device__ void init(const PG8_LAS int* offs_, int N, int G_, int c_) { offs = offs_; nN = N / BM; nwg = (offs_[16] / BM) * nN; G = G_; c = c_; }
    __device__ bool next(int i, Unit& u) const { return unit_of((long)i * G + c, u); }
    __device__ bool unit_of(const long L, Unit& u) const {
        if (L >= nwg) return false;
        int wgid = (int)L; { const int q = nwg / NXCD, r = nwg % NXCD, xcd = wgid % NXCD, off = wgid / NXCD; wgid = (xcd < r ? xcd * (q + 1) : r * (q + 1) + (xcd - r) * q) + off; }
        u.pm = wgid / nN; u.pn = wgid % nN; const int row = u.pm * BM; int e = 0;
#pragma unroll
        for (int k = 1; k < 16; ++k) e += (row >= offs[k]) ? 1 : 0;
        u.pnb = e * nN + u.pn; return true;
    }
    __device__ __forceinline__ void a_ready(const Unit&) const {}
    __device__ __forceinline__ void done(const Unit&) const {}
    __device__ __forceinline__ void done_deferred(const Unit&) const {}
};
struct GroupedSignal : GroupedOrder {
    unsigned* cnt;
    __device__ __forceinline__ void done_deferred(const Unit& u) const { if ((threadIdx.x & 63) == 0) (void)__hip_atomic_fetch_add(cnt + 64 * u.pm, 1u, __ATOMIC_RELAXED, __HIP_MEMORY_SCOPE_AGENT); }
};
struct GroupedWait : GroupedOrder {
    const unsigned* cnt; unsigned need;
    unsigned* qcnt; int xcd; PG8_LAS int* slot;
    __device__ bool next(int i, Unit& u) const {
        PG8_LAS int* sl = slot + (i & 1);
        if (threadIdx.x == 0) { int L = -1;
            for (int k = 0; k < NXCD; ++k) { const int q = (xcd + k) & (NXCD - 1); const int t = (int)__hip_atomic_fetch_add(qcnt + 64 * q, 1u, __ATOMIC_RELAXED, __HIP_MEMORY_SCOPE_AGENT); const int l = q + NXCD * t; if (l < nwg) { L = l; break; } }
            *(volatile PG8_LAS int*)sl = L; }
        asm volatile("s_waitcnt lgkmcnt(0)" ::: "memory"); __builtin_amdgcn_s_barrier(); asm volatile("" ::: "memory");
        const int L = *(volatile PG8_LAS int*)sl;
        if (L < 0) return false; return unit_of(L, u);
    }
    __device__ __forceinline__ void a_ready(const Unit& u) const {
        if (threadIdx.x < 64) { unsigned sp = 0;
            while ((unsigned)__builtin_amdgcn_readfirstlane((int)__hip_atomic_load(cnt + 64 * u.pm, __ATOMIC_RELAXED, __HIP_MEMORY_SCOPE_AGENT)) < need) { __builtin_amdgcn_s_sleep(2); if (++sp > (1u << 22)) break; }
            __builtin_amdgcn_fence(__ATOMIC_ACQUIRE, "agent");
            asm volatile("s_waitcnt vmcnt(0)" ::: "memory"); }
        asm volatile("" ::: "memory"); __builtin_amdgcn_s_barrier(); asm volatile("" ::: "memory");
    }
};
template <class Epi, class Sched, bool ALIGN_EPI = false, bool SP2 = false, bool GATHER = false>
__device__ __forceinline__ void gemm_phase(PG8_LAS unsigned char* lds, const Gemm g, const Sched& S, const Epi& E) {
    const int tid = threadIdx.x, wid = __builtin_amdgcn_readfirstlane(tid >> 6), lane = tid & 63, wr = wid >> 2, wc = wid & 3, fr = lane & 15, fq = lane >> 4;
    const int K = g.K, nt = K / BK;
    unsigned voffA[2], voffB[2];
#pragma unroll
    for (int i = 0; i < 2; ++i) { int R, C; stage_rc(tid * 16 + i * 8192, R, C); const int Rb = Epi::PERM ? ((R & ~31) + perm32(R & 31)) : R;
        voffA[i] = (unsigned)(R * K + C) * 2u; voffB[i] = (unsigned)(Rb * K + C) * 2u; }
    const size_t kstep = (size_t)(BK * 2);
    const size_t hstep = (size_t)HALF * K * 2;
    const size_t tstep = 2 * hstep;
    const unsigned ldsw = (unsigned)wid * 1024u;
    const int aoff = lds_byte(wr * 64 + fr, fq * 8), boff = lds_byte(wc * 32 + fr, fq * 8);
#define PG8_SA(b, h) (((b) * 2 + (h)) * HTB)
#define PG8_SB(b, h) ((4 + (b) * 2 + (h)) * HTB)
#define PG8_STAGE(bufoff, gbase, voff) do { _Pragma("unroll") for (int _i = 0; _i < 2; ++_i) \
        __builtin_amdgcn_global_load_lds((const unsigned*)((const char*)(gbase) + (voff)[_i]), (PG8_LAS unsigned*)(lds + (bufoff) + ldsw + _i * 8192), 16, 0, 0); } while (0)
#define PG8_STAGE_A(bufoff, gbase, half, selnext) do { if constexpr (GATHER) { unsigned vo_[2]; vo_[0] = (selnext) ? nv[half][0] : cv[half][0]; vo_[1] = (selnext) ? nv[half][1] : cv[half][1]; PG8_STAGE(bufoff, gbase, vo_); } \
        else { PG8_STAGE(bufoff, (gbase) + (half) * hstep, voffA); } } while (0)
#define PG8_LDA(dst, b, h) do { _Pragma("unroll") for (int m = 0; m < 4; ++m) _Pragma("unroll") for (int k = 0; k < 2; ++k) dst[m][k] = *(const PG8_LAS bf16x8*)(lds + PG8_SA(b, h) + aoff + m * 2048 + k * 1024); } while (0)
#define PG8_LDB(dst, b, h) do { _Pragma("unroll") for (int n = 0; n < 2; ++n) _Pragma("unroll") for (int k = 0; k < 2; ++k) dst[n][k] = *(const PG8_LAS bf16x8*)(lds + PG8_SB(b, h) + boff + n * 2048 + k * 1024); } while (0)
#define PG8_MMA(ai, bj, At, Bt) do { __builtin_amdgcn_s_setprio(1); _Pragma("unroll") for (int m = 0; m < 4; ++m) _Pragma("unroll") for (int n = 0; n < 2; ++n) _Pragma("unroll") for (int k = 0; k < 2; ++k) \
        acc[ai][bj][m][n] = __builtin_amdgcn_mfma_f32_16x16x32_bf16(Bt[n][k], At[m][k], acc[ai][bj][m][n], 0, 0, 0); __builtin_amdgcn_s_setprio(0); } while (0)
#define PG8_WAIT_V(n) asm volatile("s_waitcnt vmcnt(" #n ")" ::: "memory")
#define PG8_WAIT_L(n) asm volatile("s_waitcnt lgkmcnt(" #n ")" ::: "memory")
#define PG8_BAR __builtin_amdgcn_s_barrier()
#define PG8_SCHED __builtin_amdgcn_sched_barrier(0)
    Unit cur, nxt, prv; int ui = 0;
    if (!S.next(0, cur)) return;
    prv = cur;
    f32x4 acc[2][2][4][2];
#pragma unroll
    for (int a = 0; a < 2; ++a)
#pragma unroll
        for (int b = 0; b < 2; ++b)
#pragma unroll
            for (int m = 0; m < 4; ++m)
#pragma unroll
                for (int n = 0; n < 2; ++n) acc[a][b][m][n] = (f32x4){0.f, 0.f, 0.f, 0.f};
    bf16x8 At[4][2], B0[2][2], B1[2][2];
    unsigned cv[2][2], nv[2][2], aR[2], aC2[2];
    if constexpr (GATHER) {
#pragma unroll
        for (int i = 0; i < 2; ++i) { int R, C; stage_rc(tid * 16 + i * 8192, R, C); aR[i] = (unsigned)R; aC2[i] = (unsigned)C * 2u; }
#pragma unroll
        for (int h = 0; h < 2; ++h)
#pragma unroll
            for (int i = 0; i < 2; ++i) { cv[h][i] = (unsigned)g.sidx[h * HALF + aR[i]] * (unsigned)(K * 2) + aC2[i]; nv[h][i] = cv[h][i]; } }
    const char* cA = (const char*)g.A + (GATHER ? (size_t)0 : (size_t)cur.pm * tstep); const char* cB = (const char*)g.Bt + (size_t)cur.pnb * tstep;
    S.a_ready(cur);
    if constexpr (SP2) {
        PG8_STAGE(PG8_SB(0, 0), cB, voffB); PG8_STAGE(PG8_SB(0, 1), cB + hstep, voffB); PG8_STAGE_A(PG8_SA(0, 0), cA, 0, false); PG8_STAGE_A(PG8_SA(0, 1), cA, 1, false);
        if (wr == 1) PG8_BAR;
        PG8_WAIT_V(2); PG8_BAR;
        PG8_STAGE(PG8_SB(1, 0), cB + kstep, voffB); PG8_STAGE_A(PG8_SA(1, 0), cA + kstep, 0, false); PG8_STAGE(PG8_SB(1, 1), cB + hstep + kstep, voffB);
        PG8_WAIT_V(6); PG8_BAR;
    } else {
        PG8_STAGE(PG8_SB(0, 0), cB, voffB); PG8_STAGE_A(PG8_SA(0, 0), cA, 0, false); PG8_STAGE(PG8_SB(0, 1), cB + hstep, voffB); PG8_STAGE_A(PG8_SA(0, 1), cA, 1, false);
        if (wr == 1) PG8_BAR;
        PG8_WAIT_V(4); PG8_BAR;
        PG8_STAGE(PG8_SB(1, 0), cB + kstep, voffB); PG8_STAGE_A(PG8_SA(1, 0), cA + kstep, 0, false); PG8_STAGE(PG8_SB(1, 1), cB + hstep + kstep, voffB);
        PG8_WAIT_V(6); PG8_BAR;
    }
    for (;;) {
        const bool has_next = S.next(ui + 1, nxt);
        if constexpr (GATHER) { if (has_next) {
#pragma unroll
            for (int h = 0; h < 2; ++h)
#pragma unroll
                for (int i = 0; i < 2; ++i) nv[h][i] = (unsigned)g.sidx[(ui + 1) * BM + h * HALF + aR[i]] * (unsigned)(K * 2) + aC2[i]; } }
        const bool lastnext_ok = has_next;
        const char* nA = (has_next && !GATHER) ? (const char*)g.A + (size_t)nxt.pm * tstep : cA; const char* nB = has_next ? (const char*)g.Bt + (size_t)nxt.pnb * tstep : cB;
        for (int t = 0; t < nt; t += 2) {
            const bool last = (t == nt - 2); const bool lastnext = last && lastnext_ok;
            const char* a1 = cA + (size_t)(t + 1) * kstep;
            const char* a2 = last ? nA : cA + (size_t)(t + 2) * kstep; const char* b2 = last ? nB : cB + (size_t)(t + 2) * kstep;
            const char* a3 = a2 + kstep; const char* b3 = b2 + kstep;
            if (last && ui > 0) S.done_deferred(prv);
            if (last && has_next) S.a_ready(nxt);
            if constexpr (SP2) {
            PG8_LDB(B0, 0, 0); PG8_LDB(B1, 0, 1); PG8_SCHED; PG8_LDA(At, 0, 0); PG8_STAGE_A(PG8_SA(1, 1), a1, 1, false);
            PG8_WAIT_V(8); PG8_WAIT_L(0); PG8_BAR; PG8_MMA(0, 0, At, B0); PG8_MMA(0, 1, At, B1); PG8_BAR; PG8_SCHED;
            PG8_LDA(At, 0, 1); PG8_STAGE(PG8_SB(0, 0), b2, voffB); PG8_STAGE(PG8_SB(0, 1), b2 + hstep, voffB); PG8_STAGE_A(PG8_SA(0, 0), a2, 0, lastnext);
            PG8_WAIT_V(8); PG8_WAIT_L(0); PG8_BAR; PG8_MMA(1, 0, At, B0); PG8_MMA(1, 1, At, B1); PG8_BAR; PG8_SCHED;
            PG8_LDB(B0, 1, 0); PG8_LDB(B1, 1, 1); PG8_SCHED; PG8_LDA(At, 1, 0); PG8_STAGE_A(PG8_SA(0, 1), a2, 1, lastnext);
            PG8_WAIT_V(8); PG8_WAIT_L(0); PG8_BAR; PG8_MMA(0, 0, At, B0); PG8_MMA(0, 1, At, B1); PG8_BAR; PG8_SCHED;
            PG8_LDA(At, 1, 1); PG8_STAGE(PG8_SB(1, 0), b3, voffB); PG8_STAGE(PG8_SB(1, 1), b3 + hstep, voffB); PG8_STAGE_A(PG8_SA(1, 0), a3, 0, lastnext);
            PG8_WAIT_V(8); PG8_WAIT_L(0); PG8_BAR; PG8_MMA(1, 0, At, B0); PG8_MMA(1, 1, At, B1); PG8_BAR; PG8_SCHED;
            } else {
            PG8_LDB(B0, 0, 0); PG8_SCHED; PG8_LDA(At, 0, 0); PG8_STAGE_A(PG8_SA(1, 1), a1, 1, false);
            PG8_WAIT_L(8); PG8_BAR; PG8_WAIT_L(0); PG8_MMA(0, 0, At, B0); PG8_BAR; PG8_SCHED;
            PG8_LDB(B1, 0, 1); PG8_STAGE(PG8_SB(0, 0), b2, voffB);
            PG8_BAR; PG8_WAIT_L(0); PG8_MMA(0, 1, At, B1); PG8_BAR;
            PG8_LDA(At, 0, 1); PG8_STAGE_A(PG8_SA(0, 0), a2, 0, lastnext);
            PG8_BAR; PG8_WAIT_L(0); PG8_MMA(1, 0, At, B0); PG8_BAR; PG8_SCHED;
            PG8_STAGE(PG8_SB(0, 1), b2 + hstep, voffB);
            PG8_WAIT_V(6); PG8_BAR; PG8_MMA(1, 1, At, B1); PG8_BAR;
            PG8_LDB(B0, 1, 0); PG8_SCHED; PG8_LDA(At, 1, 0); PG8_STAGE_A(PG8_SA(0, 1), a2, 1, lastnext);
            PG8_WAIT_L(8); PG8_BAR; PG8_WAIT_L(0); PG8_MMA(0, 0, At, B0); PG8_BAR; PG8_SCHED;
            PG8_LDB(B1, 1, 1); PG8_STAGE(PG8_SB(1, 0), b3, voffB);
            PG8_BAR; PG8_WAIT_L(0); PG8_MMA(0, 1, At, B1); PG8_BAR;
            PG8_LDA(At, 1, 1); PG8_STAGE_A(PG8_SA(1, 0), a3, 0, lastnext);
            PG8_BAR; PG8_WAIT_L(0); PG8_MMA(1, 0, At, B0); PG8_BAR; PG8_SCHED;
            PG8_STAGE(PG8_SB(1, 1), b3 + hstep, voffB);
            PG8_WAIT_V(6); PG8_BAR; PG8_MMA(1, 1, At, B1); PG8_BAR;
            }
        }
        if constexpr (ALIGN_EPI) { if (wr == 0) PG8_BAR; }
        if constexpr (!Epi::AFTER_DRAIN) { E(acc, cur, wr, wc, fr, fq); S.done(cur); }
        if (!has_next) break;
#pragma unroll
        for (int a = 0; a < 2; ++a)
#pragma unroll
            for (int b = 0; b < 2; ++b)
#pragma unroll
                for (int m = 0; m < 4; ++m)
#pragma unroll
                    for (int n = 0; n < 2; ++n) acc[a][b][m][n] = (f32x4){0.f, 0.f, 0.f, 0.f};
        prv = cur; cur = nxt; cA = nA; cB = nB; ++ui;
        if constexpr (GATHER) {
#pragma unroll
            for (int h = 0; h < 2; ++h)
#pragma unroll
                for (int i = 0; i < 2; ++i) cv[h][i] = nv[h][i]; }
        if constexpr (ALIGN_EPI) { if (wr == 1) PG8_BAR; }
    }
    PG8_WAIT_V(0);
    if constexpr (!Epi::AFTER_DRAIN) S.done_deferred(cur);
    if constexpr (!ALIGN_EPI) { if (wr == 0) PG8_BAR; }
    PG8_BAR;
    if constexpr (Epi::AFTER_DRAIN) { E.fused(acc, cur, wr, wc, fr, fq, lds, wid, lane); S.done(cur); }
#undef PG8_SA
#undef PG8_SB
#undef PG8_STAGE
#undef PG8_STAGE_A
#undef PG8_LDA
#undef PG8_LDB
#undef PG8_MMA
#undef PG8_WAIT_V
#undef PG8_WAIT_L
#undef PG8_BAR
#undef PG8_SCHED
}
}

#define XB_TMO      128
#define XB_XCNT(j)  (256  + 64 * (j))
#define XB_XSUB(j)  (1280 + 64 * (j))
#define XB_XGEN(j)  (2304 + 64 * (j))
#define XB_TOP      3328
#define XB_TOPGEN   3392
#define XCD_BAR_WORDS 3456
#define XB_SPIN_CAP (1u << 18)
__device__ __forceinline__ unsigned xb_ld(unsigned* p)              { return __hip_atomic_load(p, __ATOMIC_RELAXED, __HIP_MEMORY_SCOPE_AGENT); }
__device__ __forceinline__ unsigned xb_add(unsigned* p, unsigned v) { return __hip_atomic_fetch_add(p, v, __ATOMIC_RELAXED, __HIP_MEMORY_SCOPE_AGENT); }
__device__ __forceinline__ unsigned xb_xcc_id() { return (unsigned)__builtin_amdgcn_s_getreg((3 << 11) | 20) & 0xFu; }
#define XB_SPIN(cond, bar) do { unsigned _sp = 0; while (cond) { __builtin_amdgcn_s_sleep(1); \
    if ((++_sp & 255u) == 0u) { if (xb_ld(&(bar)[XB_TMO])) break; if (_sp > XB_SPIN_CAP) { atomicAdd(&(bar)[XB_TMO], 1u); break; } } } } while (0)
struct XcdBarrier { unsigned* bar; unsigned x; volatile LAS unsigned* st; };
__device__ __forceinline__ XcdBarrier xcd_barrier_post(unsigned* bar, volatile LAS unsigned* st) {
    XcdBarrier b; b.bar = bar; b.x = xb_xcc_id(); b.st = st;
    if (threadIdx.x == 0) (void)xb_add(&bar[XB_XCNT(b.x)], 1u);
    return b;
}
__device__ __forceinline__ void xcd_barrier_complete(unsigned* bar, unsigned x, unsigned& nloc, unsigned& nx) {
    const unsigned G = gridDim.x * gridDim.y * gridDim.z;
    unsigned sum, cnt, mine, sp = 0u;
    for (;;) {
        sum = 0u; cnt = 0u; mine = 0u;
#pragma unroll
        for (unsigned j = 0; j < 16; ++j) { const unsigned c = xb_ld(&bar[XB_XCNT(j)]); sum += c; cnt += (c > 0u) ? 1u : 0u; mine = (j == x) ? c : mine; }
        if (sum == G) break;
        __builtin_amdgcn_s_sleep(1);
        if ((++sp & 255u) == 0u) { if (xb_ld(&bar[XB_TMO])) break; if (sp > XB_SPIN_CAP) { atomicAdd(&bar[XB_TMO], 1u); break; } }
    }
    nloc = mine > 0u ? mine : 1u; nx = cnt > 0u ? cnt : 1u;
}
__device__ __forceinline__ void xcd_barrier(const XcdBarrier& b) {
    asm volatile("s_waitcnt vmcnt(0)" ::: "memory");
    __syncthreads();
    if (threadIdx.x == 0) {
        unsigned* bar = b.bar;
        __builtin_amdgcn_s_waitcnt(0);
        unsigned nloc = b.st[0], nx = b.st[1];
        if (nloc == 0u) { xcd_barrier_complete(bar, b.x, nloc, nx); b.st[0] = nloc; b.st[1] = nx; }
        const unsigned old = xb_add(&bar[XB_XSUB(b.x)], 1u);
        const unsigned gen = old / nloc;
        if (old + 1u == (gen + 1u) * nloc) {
            __builtin_amdgcn_fence(__ATOMIC_RELEASE, "agent");
            asm volatile("s_waitcnt vmcnt(0)" ::: "memory");
            const unsigned og = xb_add(&bar[XB_TOP], 1u);
            const unsigned tg = og / nx;
            if (og + 1u == (tg + 1u) * nx) xb_add(&bar[XB_TOPGEN], 1u);
            else XB_SPIN(xb_ld(&bar[XB_TOPGEN]) == tg, bar);
            __builtin_amdgcn_fence(__ATOMIC_ACQUIRE, "agent");
            xb_add(&bar[XB_XGEN(b.x)], 1u);
            asm volatile("s_waitcnt vmcnt(0)" ::: "memory");
        } else {
            XB_SPIN(xb_ld(&bar[XB_XGEN(b.x)]) == gen, bar);
            __builtin_amdgcn_fence(__ATOMIC_ACQUIRE, "agent");
            asm volatile("s_waitcnt vmcnt(0)" ::: "memory");
        }
    }
    __syncthreads();
}
constexpr int CW_YA = 8192;
constexpr int CW_BAR = 4096;

struct Args { const float* in[23]; float* out; unsigned char* ws; int ph_lo, ph_hi, li, pad; };
enum { I_X = 0, I_C, I_WADA, I_BADA, I_GPREMIX, I_GPOSTMIX, I_WIN, I_LNVG, I_LNVB, I_WSP, I_BSP, I_LBL, I_GHGRN, I_WOUT, I_GPREFFN, I_GPOSTFFN, I_WRG, I_BRG, I_WRE, I_BRE, I_W1, I_W3, I_W2 };
enum { PH_PREP = 0, PH_HNORM, PH_INPROJ, PH_MIXA, PH_MIXB, PH_OUTPROJ, PH_ROW1, PH_GATHER, PH_MOE1, PH_MOE2, PH_FINAL, PH_N };

struct Frame {
    LAS unsigned char* lds;
    int tid, lane, wave, vcu, G;
};
typedef const __attribute__((address_space(4))) Args KArgs;
__device__ __forceinline__ KArgs* kargs() { KArgs* p = (KArgs*)__builtin_amdgcn_kernarg_segment_ptr(); asm volatile("" : "+s"(p)); return p; }

__host__ __device__ __forceinline__ size_t blk(size_t row, int col) { return ((row >> 4) * 32 + (size_t)(col >> 5)) * 512 + (row & 15) * 32 + (col & 31); }
__host__ __device__ __forceinline__ int inproj_row(int n) {
    const int s = n >> 10, ch = n & 1023, j = ch >> 7, cc = ch & 127;
    const int type = (s == 0 || s == 6) ? 0 : (s == 5 || s == 7) ? 1 : (s == 1 || s == 2) ? 2 : 3;
    const int bj = (s == 0 || s == 5 || s == 1 || s == 3) ? 0 : 1;
    return 256 * (4 * j + type) + 128 * bj + cc;
}

__device__ __forceinline__ void transpose_item(const float* W, int N, int k0, int n0, bf16* WT, int Kd, int r0, LAS float* scr, int lane) {
    const int kr = lane >> 3, nq = lane & 7;
    f32x4 v[8];
#pragma unroll
    for (int i = 0; i < 8; ++i) v[i] = *(const f32x4*)(W + (size_t)(k0 + 8 * i + kr) * N + n0 + 4 * nq);
#pragma unroll
    for (int i = 0; i < 8; ++i) { LAS float* d = scr + (8 * i + kr) * 33 + 4 * nq; d[0] = v[i][0]; d[1] = v[i][1]; d[2] = v[i][2]; d[3] = v[i][3]; }
    LDS_WAIT(); asm volatile("" ::: "memory");
    const int c = lane & 7;
#pragma unroll
    for (int j = 0; j < 4; ++j) { const int n = (lane >> 3) + 8 * j; const LAS float* s = scr + (8 * c) * 33 + n;
        v4u o; o.x = pk2(s[0 * 33], s[1 * 33]); o.y = pk2(s[2 * 33], s[3 * 33]); o.z = pk2(s[4 * 33], s[5 * 33]); o.w = pk2(s[6 * 33], s[7 * 33]);
        *(GAS v4u*)(WT + (size_t)(r0 + n) * Kd + k0 + 8 * c) = o; }
    LDS_WAIT(); asm volatile("" ::: "memory");
}

struct TrDesc { const float* W; bf16* WT; int N, k0, n0, Kd, r0; };
template <bool NT> __device__ __forceinline__ f32x4 tr_ld(const f32x4* p) { return NT ? __builtin_nontemporal_load(p) : *p; }
template <bool NT = false> __device__ __forceinline__ void tr_load(f32x4 (&v)[8], const TrDesc& d, int lane) {
    const int kr = lane >> 3, nq = lane & 7;
#pragma unroll
    for (int i = 0; i < 8; ++i) v[i] = tr_ld<NT>((const f32x4*)(d.W + (size_t)(d.k0 + 8 * i + kr) * d.N + d.n0 + 4 * nq));
    asm volatile("" ::: "memory");
}
__device__ __forceinline__ void tr_to_lds(const f32x4 (&v)[8], LAS float* scr, int lane) {
    const int kr = lane >> 3, nq = lane & 7;
#pragma unroll
    for (int i = 0; i < 8; ++i) { LAS float* d = scr + (8 * i + kr) * 33 + 4 * nq; d[0] = v[i][0]; d[1] = v[i][1]; d[2] = v[i][2]; d[3] = v[i][3]; }
    LDS_WAIT(); asm volatile("" ::: "memory");
}
template <bool NT = false> __device__ __forceinline__ void tr_store(const TrDesc& d, LAS float* scr, int lane) {
    const int c = lane & 7;
#pragma unroll
    for (int j = 0; j < 4; ++j) { const int n = (lane >> 3) + 8 * j; const LAS float* s = scr + (8 * c) * 33 + n;
        v4u o; o.x = pk2(s[0 * 33], s[1 * 33]); o.y = pk2(s[2 * 33], s[3 * 33]); o.z = pk2(s[4 * 33], s[5 * 33]); o.w = pk2(s[6 * 33], s[7 * 33]);
        if (NT) __builtin_nontemporal_store(o, (v4u*)(d.WT + (size_t)(d.r0 + n) * d.Kd + d.k0 + 8 * c)); else *(GAS v4u*)(d.WT + (size_t)(d.r0 + n) * d.Kd + d.k0 + 8 * c) = o; }
    LDS_WAIT(); asm volatile("" ::: "memory");
}
#define TR_PIPELINE(DEC, it0_, stride_, nit_, tv, scr, lane, PRELOADED, NT) do { int it_ = (it0_); if (it_ < (nit_)) { TrDesc d_ = DEC(it_); if (!(PRELOADED)) tr_load<NT>(tv, d_, lane); \
        for (;;) { tr_to_lds(tv, scr, lane); const int nx_ = it_ + (stride_); const bool more_ = nx_ < (nit_); const TrDesc dn_ = DEC(more_ ? nx_ : it_); \
            tr_load<NT>(tv, dn_, lane);                \
            tr_store<NT>(d_, scr, lane); if (!more_) break; d_ = dn_; it_ = nx_; } } } while (0)

__device__ __forceinline__ void phase_prep(Frame& F) {
    const KArgs* ap_ = kargs(); const KArgs& a = *ap_; unsigned char* ws = a.ws;
    if (F.vcu == F.G - 1) { const float* lbl = a.in[I_LBL]; float* lbv = (float*)(ws + WS_LBV);
        for (int c = F.tid; c < D; c += NTHREADS) lbv[c] = 1.0f / (1.0f + expf(lbl[D + c] - lbl[c])); }
    LAS float* sc = (LAS float*)F.lds;
    LAS float* red = (LAS float*)(F.lds + 65536);
    bool have_sc = false;
    for (int u = F.vcu; u < 6144 / 32; u += F.G) {
        if (!have_sc) { const float* c = a.in[I_C];
            for (int i = F.tid; i < 16 * D; i += NTHREADS) sc[i] = silu_f(c[i]);
            have_sc = true; __syncthreads(); }
        const int col = F.tid & 31, kq = F.tid >> 5, j0 = 32 * u;
        float acc[16];
#pragma unroll
        for (int b = 0; b < 16; ++b) acc[b] = 0.f;
        const float* w = a.in[I_WADA] + (size_t)(64 * kq) * 6144 + j0 + col;
        for (int kk = 0; kk < 64; kk += 8) { float wv[8];
#pragma unroll
            for (int q = 0; q < 8; ++q) wv[q] = w[(size_t)(kk + q) * 6144];
#pragma unroll
            for (int b = 0; b < 16; ++b) { const f32x4 s0 = *(const LAS f32x4*)(sc + b * D + 64 * kq + kk), s1 = *(const LAS f32x4*)(sc + b * D + 64 * kq + kk + 4);
                acc[b] += (s0.x * wv[0] + s0.y * wv[1]) + (s0.z * wv[2] + s0.w * wv[3]) + (s1.x * wv[4] + s1.y * wv[5]) + (s1.z * wv[6] + s1.w * wv[7]); } }
#pragma unroll
        for (int b = 0; b < 16; ++b) red[(kq * 16 + b) * 32 + col] = acc[b];
        __syncthreads();
        { const int b = F.tid >> 5; float s = 0.f;
#pragma unroll
          for (int q = 0; q < 16; ++q) s += red[(q * 16 + b) * 32 + col];
          ((float*)(ws + WS_ADA))[b * 6144 + j0 + col] = s + a.in[I_BADA][j0 + col]; }
        __syncthreads();
    }
}

__device__ __forceinline__ void phase_hnorm(Frame& F) {
    const KArgs* ap_ = kargs(); const KArgs& a = *ap_; unsigned char* ws = a.ws;
    const float* ada = (const float*)(ws + WS_ADA); const float* x = a.in[I_X]; const float* g = a.in[I_GPREMIX]; bf16* H = (bf16*)(ws + WS_H);
    const int rows_per = T / F.G, row0 = (int)blockIdx.x * rows_per;
    f32x4 gs[4], shv[4];
    { const float* ab = ada + (size_t)(row0 / SEQ) * 6144;
#pragma unroll
      for (int j = 0; j < 4; ++j) { const int c = 256 * j + 4 * F.lane; gs[j] = *(const f32x4*)(g + c) * (*(const f32x4*)(ab + D + c) + 1.0f); shv[j] = *(const f32x4*)(ab + c); } }
    constexpr int R = 4; const int step = R * NWAVES, n_it = rows_per / step;
    f32x4 va[R][4], vb[R][4];
#define HN_LOAD(V, i0_) do { _Pragma("unroll") for (int r = 0; r < R; ++r) { const f32x4* xr = (const f32x4*)(x + (size_t)(row0 + (i0_) + r * NWAVES) * D) + F.lane; \
            _Pragma("unroll") for (int j = 0; j < 4; ++j) V[r][j] = xr[64 * j]; } asm volatile("" ::: "memory"); } while (0)
#define HN_COMP(V, i0_) do { float s[R]; \
        _Pragma("unroll") for (int r = 0; r < R; ++r) { float t = 0.f; \
            _Pragma("unroll") for (int j = 0; j < 4; ++j) t += (V[r][j].x * V[r][j].x + V[r][j].y * V[r][j].y) + (V[r][j].z * V[r][j].z + V[r][j].w * V[r][j].w); \
            s[r] = t; } \
        _Pragma("unroll") for (int o = 1; o < 64; o <<= 1) { _Pragma("unroll") for (int r = 0; r < R; ++r) s[r] += __shfl_xor(s[r], o); } \
        _Pragma("unroll") for (int r = 0; r < R; ++r) { const float rstd = __builtin_amdgcn_rsqf(s[r] * (1.f / D) + RMS_EPS); \
            unsigned long long* o8 = (unsigned long long*)(H + (size_t)(row0 + (i0_) + r * NWAVES) * D) + F.lane; \
            _Pragma("unroll") for (int j = 0; j < 4; ++j) { const f32x4 h = V[r][j] * rstd * gs[j] + shv[j]; \
                o8[64 * j] = (unsigned long long)pk2(h.x, h.y) | ((unsigned long long)pk2(h.z, h.w) << 32); } } } while (0)
    LAS float* scr = (LAS float*)(F.lds + F.wave * 16384);
    const int gw = F.vcu * NWAVES + F.wave, NGW = F.G * NWAVES;
    constexpr int I_IN = (D / 64) * (NIN / 32), I_OUT = (D / 64) * (D / 32);
    const float* win = a.in[I_WIN]; const float* wout = a.in[I_WOUT];
    auto dec = [&](int it) -> TrDesc { TrDesc d;
        if (it < I_IN) { const int kb = it / (NIN / 32), nb = it % (NIN / 32); d.W = win; d.N = NIN; d.k0 = 64 * kb; d.n0 = 32 * nb; d.WT = (bf16*)(ws + WS_WIN); d.Kd = D; d.r0 = inproj_row(32 * nb); }
        else { const int r = it - I_IN, kb = r / (D / 32), nb = r % (D / 32); d.W = wout; d.N = D; d.k0 = 64 * kb; d.n0 = 32 * nb; d.WT = (bf16*)(ws + WS_WOUT); d.Kd = D; d.r0 = 32 * nb; }
        return d; };
    f32x4 tv[8];
    HN_LOAD(va, F.wave);
    for (int k = 0; k + 2 < n_it; k += 2) {
        HN_LOAD(vb, F.wave + (k + 1) * step); HN_COMP(va, F.wave + k * step);
        HN_LOAD(va, F.wave + (k + 2) * step); HN_COMP(vb, F.wave + (k + 1) * step); }
    { const int k = n_it - 2;
        HN_LOAD(vb, F.wave + (k + 1) * step); HN_COMP(va, F.wave + k * step);
        { const TrDesc d0 = dec(min(gw, I_IN + I_OUT - 1)); tr_load(tv, d0, F.lane); }
        HN_COMP(vb, F.wave + (k + 1) * step); }
#undef HN_LOAD
#undef HN_COMP
    TR_PIPELINE(dec, gw, NGW, I_IN + I_OUT, tv, scr, F.lane, true, false);
}

__device__ __forceinline__ float reduce8_transpose(const float (&a)[8], unsigned lane) {
    float b[4], c[2], d;
    { const bool up = (lane & 32) != 0;
#pragma unroll
      for (int k = 0; k < 4; ++k) { const float keep = up ? a[k + 4] : a[k], send = up ? a[k] : a[k + 4]; b[k] = keep + __shfl_xor(send, 32); } }
    { const bool up = (lane & 16) != 0;
#pragma unroll
      for (int k = 0; k < 2; ++k) { const float keep = up ? b[k + 2] : b[k], send = up ? b[k] : b[k + 2]; c[k] = keep + __shfl_xor(send, 16); } }
    { const bool up = (lane & 8) != 0; const float keep = up ? c[1] : c[0], send = up ? c[0] : c[1]; d = keep + __shfl_xor(send, 8); }
    d += __shfl_xor(d, 4); d += __shfl_xor(d, 2); d += __shfl_xor(d, 1);
    return d;
}
__device__ __forceinline__ void phase_row1(Frame& F) {
    const KArgs* ap_ = kargs(); const KArgs& a = *ap_; unsigned char* ws = a.ws;
    const float* ada = (const float*)(ws + WS_ADA); const float* x = a.in[I_X]; const bf16* y2 = (const bf16*)(ws + WS_Y2);
    const float* gpost = a.in[I_GPOSTMIX]; const float* gpre = a.in[I_GPREFFN];
    const float* wrg = a.in[I_WRG]; const float* brg = a.in[I_BRG]; const float* wre = a.in[I_WRE]; const float* bre = a.in[I_BRE];
    bf16* X1B = (bf16*)(ws + WS_X1); bf16* H2 = (bf16*)(ws + WS_H2); int* EID = (int*)(ws + WS_EID); float* EW = (float*)(ws + WS_EW); int* RANK = (int*)(ws + WS_RANK); int* CNT = (int*)(ws + WS_CNT);
    LAS f32x4* s_wre = (LAS f32x4*)F.lds;
    LAS f32x4* s_wrg = (LAS f32x4*)(F.lds + 65536);
    LAS int* s_eid = (LAS int*)(F.lds + 81920);
    LAS float* s_rb = (LAS float*)(F.lds + 83968 + 8 * 256 * 4);
    if (F.tid < 4) s_rb[F.tid] = brg[F.tid]; else if (F.tid < 20) s_rb[F.tid] = bre[F.tid - 4];
#pragma unroll
    for (int k = 0; k < 8; ++k) { const int n = F.tid + NTHREADS * k, ln = n & 63, o4 = (n >> 6) & 3, jq = n >> 8, c = 256 * (jq >> 2) + 4 * ln + (jq & 3);
        s_wre[n] = *(const f32x4*)(wre + (size_t)c * 16 + 4 * o4); }
#pragma unroll
    for (int k = 0; k < 2; ++k) { const int n = F.tid + NTHREADS * k, ln = n & 63, jq = n >> 6, c = 256 * (jq >> 2) + 4 * ln + (jq & 3);
        s_wrg[n] = *(const f32x4*)(wrg + (size_t)c * 4); }
    __syncthreads();
    const int rows_per = T / F.G, row0 = (int)blockIdx.x * rows_per;
    constexpr int R = 2;
    const LAS f32x4* wre_l = s_wre + F.lane; const LAS f32x4* wrg_l = s_wrg + F.lane;
    asm volatile("" : "+v"(wre_l), "+v"(wrg_l));
    f32x4 gtg[4], gs[4], shv[4];
    { const float* ab = ada + (size_t)(row0 / SEQ) * 6144;
#pragma unroll
      for (int j = 0; j < 4; ++j) { const int c = 256 * j + 4 * F.lane;
          gtg[j] = *(const f32x4*)(ab + 2 * D + c) * *(const f32x4*)(gpost + c); gs[j] = *(const f32x4*)(gpre + c) * (*(const f32x4*)(ab + 4 * D + c) + 1.0f); shv[j] = *(const f32x4*)(ab + 3 * D + c); } }
    f32x4 xv[R][4]; v2u yu[R][4];
#define R1_LOAD(i0_) do { _Pragma("unroll") for (int r = 0; r < R; ++r) { const int m = row0 + (i0_) + r * NWAVES; \
            const v2u* yr = (const v2u*)(y2 + (size_t)m * D) + F.lane; const f32x4* xr = (const f32x4*)(x + (size_t)m * D) + F.lane; \
            _Pragma("unroll") for (int j = 0; j < 4; ++j) { yu[r][j] = yr[64 * j]; xv[r][j] = xr[64 * j]; } } asm volatile("" ::: "memory"); } while (0)
    R1_LOAD(F.wave);
    for (int i0 = F.wave; i0 < rows_per; i0 += R * NWAVES) {
        f32x4 v[R][4]; float s[R];
#pragma unroll
        for (int r = 0; r < R; ++r) { float t = 0.f;
#pragma unroll
            for (int j = 0; j < 4; ++j) { const v2u yy = yu[r][j]; v[r][j] = (f32x4){bf2f(yy.x & 0xffffu), bf2f(yy.x >> 16), bf2f(yy.y & 0xffffu), bf2f(yy.y >> 16)};
                t += (v[r][j].x * v[r][j].x + v[r][j].y * v[r][j].y) + (v[r][j].z * v[r][j].z + v[r][j].w * v[r][j].w); }
            s[r] = t; }
#pragma unroll
        for (int o = 1; o < 64; o <<= 1) {
#pragma unroll
            for (int r = 0; r < R; ++r) s[r] += __shfl_xor(s[r], o); }
        float s2[R];
#pragma unroll
        for (int r = 0; r < R; ++r) { const int m = row0 + i0 + r * NWAVES;
            const float r1 = __builtin_amdgcn_rsqf(s[r] * (1.f / D) + RMS_EPS); float t = 0.f;
#pragma unroll
            for (int j = 0; j < 4; ++j) {
                v[r][j] = xv[r][j] + gtg[j] * (v[r][j] * r1);
                __builtin_nontemporal_store((unsigned long long)pk2(v[r][j].x, v[r][j].y) | ((unsigned long long)pk2(v[r][j].z, v[r][j].w) << 32), (unsigned long long*)(X1B + (size_t)m * D) + F.lane + 64 * j);
                t += (v[r][j].x * v[r][j].x + v[r][j].y * v[r][j].y) + (v[r][j].z * v[r][j].z + v[r][j].w * v[r][j].w); }
            s2[r] = t; }
        R1_LOAD((i0 + R * NWAVES < rows_per) ? i0 + R * NWAVES : i0);
#pragma unroll
        for (int o = 1; o < 64; o <<= 1) {
#pragma unroll
            for (int r = 0; r < R; ++r) s2[r] += __shfl_xor(s2[r], o); }
#pragma unroll
        for (int r = 0; r < R; ++r) { const int m = row0 + i0 + r * NWAVES;
            const float r2 = __builtin_amdgcn_rsqf(s2[r] * (1.f / D) + RMS_EPS);
            unsigned long long* o8 = (unsigned long long*)(H2 + (size_t)m * D) + F.lane;
#pragma unroll
            for (int j = 0; j < 4; ++j) {
                const f32x4 h = v[r][j] * r2 * gs[j] + shv[j]; v[r][j] = h;
                o8[64 * j] = (unsigned long long)pk2(h.x, h.y) | ((unsigned long long)pk2(h.z, h.w) << 32); } }
        LAS float* s_lg = (LAS float*)(F.lds + 83968 + F.wave * 256);
        float pa[4 * R];
#pragma unroll
        for (int k = 0; k < 4 * R; ++k) pa[k] = 0.f;
#pragma unroll
        for (int j = 0; j < 4; ++j) {
#pragma unroll
            for (int q = 0; q < 4; ++q) { const f32x4 wg = wrg_l[(4 * j + q) * 64];
#pragma unroll
                for (int r = 0; r < R; ++r) { const float hv = v[r][j][q]; pa[4 * r] += hv * wg.x; pa[4 * r + 1] += hv * wg.y; pa[4 * r + 2] += hv * wg.z; pa[4 * r + 3] += hv * wg.w; } }
            asm volatile("" ::: "memory"); }
        s_lg[(F.lane >> 3) & 7] = reduce8_transpose(pa, F.lane);
        int gi_[R]; float ptop_[R];
#pragma unroll
        for (int r = 0; r < R; ++r) { const f32x4 glv = *(const LAS f32x4*)(s_lg + 4 * r);
            float gl[4] = {glv.x + s_rb[0], glv.y + s_rb[1], glv.z + s_rb[2], glv.w + s_rb[3]}; int gi = 0;
            float gm = gl[0];
#pragma unroll
            for (int q = 1; q < 4; ++q) if (gl[q] > gm) { gm = gl[q]; gi = q; }
            float gsum = 0.f;
#pragma unroll
            for (int q = 0; q < 4; ++q) gsum += __expf(gl[q] - gm);
            gi_[r] = gi; ptop_[r] = __builtin_amdgcn_rcpf(gsum); }
#pragma unroll
        for (int k = 0; k < 4 * R; ++k) pa[k] = 0.f;
#pragma unroll
        for (int r = 0; r < R; ++r) { const LAS f32x4* wr = wre_l + gi_[r] * 64;
#pragma unroll
            for (int j = 0; j < 4; ++j) {
#pragma unroll
                for (int q = 0; q < 4; ++q) { const f32x4 we = wr[(4 * j + q) * 256]; const float hv = v[r][j][q];
                    pa[4 * r] += hv * we.x; pa[4 * r + 1] += hv * we.y; pa[4 * r + 2] += hv * we.z; pa[4 * r + 3] += hv * we.w; }
                asm volatile("" ::: "memory"); } }
        s_lg[8 + ((F.lane >> 3) & 7)] = reduce8_transpose(pa, F.lane);
#pragma unroll
        for (int r = 0; r < R; ++r) { const int i = i0 + r * NWAVES, m = row0 + i;
            const int gi = gi_[r]; const float ptop = ptop_[r];
            const f32x4 elv = *(const LAS f32x4*)(s_lg + 8 + 4 * r), brv = *(const LAS f32x4*)(s_rb + 4 + 4 * gi);
            float el[4]; el[0] = elv.x + brv.x; el[1] = elv.y + brv.y; el[2] = elv.z + brv.z; el[3] = elv.w + brv.w;
            int i0e = 0; float m0 = el[0];
#pragma unroll
            for (int q = 1; q < 4; ++q) if (el[q] > m0) { m0 = el[q]; i0e = q; }
            int i1 = -1; float m1 = -INFINITY;
#pragma unroll
            for (int q = 0; q < 4; ++q) if (q != i0e && el[q] > m1) { m1 = el[q]; i1 = q; }
            if (i1 < 0) { i1 = (i0e + 1) & 3; m1 = m0; }
            const float e1 = __expf(m1 - m0), w0 = ptop * __builtin_amdgcn_rcpf(1.0f + e1), w1 = w0 * e1;
            if (F.lane == 0) { EID[2 * m] = 4 * gi + i0e; EID[2 * m + 1] = 4 * gi + i1; EW[2 * m] = w0; EW[2 * m + 1] = w1; s_eid[2 * i] = 4 * gi + i0e; s_eid[2 * i + 1] = 4 * gi + i1; }
        }
    }
#undef R1_LOAD
    __syncthreads();
    LAS int* s_wc = (LAS int*)(F.lds + 83968 + 8192 + 128);
    int my_e = -1, my_rank = 0;
    if ((int)F.tid < 2 * rows_per) { my_e = s_eid[F.tid];
#pragma unroll
        for (int ee = 0; ee < NE; ++ee) { const unsigned long long mk = __ballot(my_e == ee);
            if (my_e == ee) my_rank = (int)__builtin_amdgcn_mbcnt_hi((unsigned)(mk >> 32), __builtin_amdgcn_mbcnt_lo((unsigned)mk, 0u));
            if ((int)F.lane == ee) s_wc[F.wave * NE + ee] = __popcll(mk); } }
    else if (F.lane < NE) s_wc[F.wave * NE + F.lane] = 0;
    __syncthreads();
    LAS int* s_gb = s_wc + NWAVES * NE;
    if (F.tid < NE) { int c = 0;
#pragma unroll
        for (int w = 0; w < NWAVES; ++w) c += s_wc[w * NE + F.tid];
        s_gb[F.tid] = (int)__hip_atomic_fetch_add((unsigned*)(ws + WS_CTL) + CW_TOT + 64 * F.tid, (unsigned)c, __ATOMIC_RELAXED, __HIP_MEMORY_SCOPE_AGENT); }
    __syncthreads();
    if ((int)F.tid < 2 * rows_per) { int base = s_gb[my_e];
        for (int w = 0; w < F.wave; ++w) base += s_wc[w * NE + my_e];
        const int lr = base + my_rank;
        RANK[2 * row0 + F.tid] = lr; ((int*)(ws + WS_IDXREL))[my_e * 65536 + lr] = row0 + ((int)F.tid >> 1); }
    __syncthreads();
}

typedef short v4i16 __attribute__((ext_vector_type(4)));
__device__ __forceinline__ unsigned offb(unsigned row, unsigned ch) { return 256u * row + 16u * (ch ^ (((row & 3u) << 2) | ((row >> 2) & 3u))); }
__device__ __forceinline__ unsigned rra16(unsigned lane, unsigned rb, unsigned s) { return offb((lane & 15u) + 16u * rb, 4u * s + (lane >> 4)); }
__device__ __forceinline__ unsigned tra16(unsigned lane, unsigned c, unsigned ks, unsigned t) { const unsigned g = lane >> 4, q = (lane & 15u) >> 2, p = lane & 3u; return offb(32u * ks + 8u * g + 4u * t + q, 2u * c + (p >> 1)) + 8u * (p & 1u); }
__device__ __forceinline__ bf16x8 ldrow(LAS unsigned char* img, unsigned off) { return *(const LAS bf16x8*)(img + off); }
__device__ __forceinline__ bf16x8 ldtr(LAS unsigned char* img, unsigned off0, unsigned off1) {
    const v4i16 x = __builtin_amdgcn_ds_read_tr16_b64_v4i16((LAS v4i16*)(img + off0)), y = __builtin_amdgcn_ds_read_tr16_b64_v4i16((LAS v4i16*)(img + off1));
    return (bf16x8){x[0], x[1], x[2], x[3], y[0], y[1], y[2], y[3]};
}
typedef __bf16 bf16x2_t __attribute__((ext_vector_type(2)));
__device__ __forceinline__ unsigned cvtpk(float lo, float hi) { const f32x2 v = {lo, hi}; const bf16x2_t b = __builtin_convertvector(v, bf16x2_t); return __builtin_bit_cast(unsigned, b); }
__device__ __forceinline__ float bflo(unsigned u) { return __builtin_bit_cast(float, u << 16); }
__device__ __forceinline__ float bfhi(unsigned u) { return __builtin_bit_cast(float, u & 0xffff0000u); }
__device__ __forceinline__ unsigned spoff(unsigned v, unsigned ch) { return 256u * v + 16u * (ch ^ v); }
__device__ __forceinline__ unsigned poff(unsigned t, unsigned ch) { return 128u * t + 16u * (ch ^ (t & 7u)); }
__device__ __forceinline__ unsigned zvoff(unsigned t, unsigned ch) { return 256u * t + 16u * (ch ^ (t & 15u)); }
constexpr int MA_WC = 0, MA_VN = 32768, MA_ZV = 65536, MA_MU = 98304, MA_RS = 98816, MA_CST = 99328;
__device__ __forceinline__ void mixa_units(Frame& F, const int gg, const int u0, const int du, const int nu, unsigned* flag) {
    const KArgs* ap_ = kargs(); const KArgs& a = *ap_; unsigned char* ws = a.ws;
    const bf16 *GAU = (const bf16*)(ws + WS_GAU), *GV = (const bf16*)(ws + WS_GV); const float* VSTAT = (const float*)(ws + WS_VSTAT); bf16* Y = (bf16*)(ws + WS_H);
    const int tid = F.tid, w = F.wave, crow = tid >> 4, cch = tid & 15;
    const __amdgpu_buffer_rsrc_t yrs = __builtin_amdgcn_make_buffer_rsrc(Y, 0, T * D * 2, 0x00020000);
    LAS unsigned char* const WC = F.lds + MA_WC; LAS unsigned char* const VN = F.lds + MA_VN; LAS unsigned char* const ZV = F.lds + MA_ZV;
    LAS float* const s_mu = (LAS float*)(F.lds + MA_MU); LAS float* const s_rs = (LAS float*)(F.lds + MA_RS);
    LAS float* const s_lng = (LAS float*)(F.lds + MA_CST); LAS float* const s_lnb = s_lng + 128; LAS float* const s_bsp = s_lng + 256;
    { const float* W = a.in[I_WSP] + (size_t)gg * 16384;
#pragma unroll
      for (int k = 0; k < 4; ++k) { const int row = crow + 32 * k; const f32x4 w0 = *(const f32x4*)(W + row * 128 + 8 * cch), w1 = *(const f32x4*)(W + row * 128 + 8 * cch + 4);
          float v[8] = {w0[0], w0[1], w0[2], w0[3], w1[0], w1[1], w1[2], w1[3]};
#pragma unroll
          for (int i = 0; i < 8; ++i) v[i] = (8 * cch + i <= row) ? v[i] : 0.f;
          v4u o; o.x = cvtpk(v[0], v[1]); o.y = cvtpk(v[2], v[3]); o.z = cvtpk(v[4], v[5]); o.w = cvtpk(v[6], v[7]);
          *(LAS v4u*)(WC + offb(row, cch)) = o; } }
    if (tid < 128) { s_lng[tid] = a.in[I_LNVG][128 * gg + tid]; s_lnb[tid] = a.in[I_LNVB][128 * gg + tid]; s_bsp[tid] = a.in[I_BSP][128 * gg + tid]; }
    for (int ui = 0; ui < nu; ++ui) { const int u = u0 + ui * du;
        const size_t t0 = (size_t)(u >> 4) * SEQ + 128 * (u & 15);
        unsigned lane = F.lane; asm volatile("" : "+v"(lane));
        const unsigned g = lane >> 4, l15 = lane & 15;
        v4u gvr[4], gar[4];
#pragma unroll
        for (int k = 0; k < 4; ++k) { const size_t off = blk(t0 + crow + 32 * k, 128 * gg + 8 * cch); gvr[k] = *(const v4u*)(GV + off); gar[k] = *(const v4u*)(GAU + off); }
        float mu_ = 0.f, rs_ = 0.f;
        if (tid < 128) { const f32x4* p = (const f32x4*)(VSTAT + (t0 + tid) * 64); float s = 0.f, ss = 0.f;
#pragma unroll
            for (int q = 0; q < 16; ++q) { const f32x4 v = p[q]; s += v[0] + v[2]; ss += v[1] + v[3]; }
            mu_ = s * (1.f / D); rs_ = __builtin_amdgcn_rsqf(ss * (1.f / D) - mu_ * mu_ + LN_EPS); }
        __syncthreads();
        if (tid < 128) { s_mu[tid] = mu_; s_rs[tid] = rs_; }
        __syncthreads();
        { float lng[8], lnb[8];
          { const f32x4 a0 = *(const LAS f32x4*)(s_lng + 8 * cch), a1 = *(const LAS f32x4*)(s_lng + 8 * cch + 4), b0 = *(const LAS f32x4*)(s_lnb + 8 * cch), b1 = *(const LAS f32x4*)(s_lnb + 8 * cch + 4);
#pragma unroll
            for (int i = 0; i < 4; ++i) { lng[i] = a0[i]; lng[4 + i] = a1[i]; lnb[i] = b0[i]; lnb[4 + i] = b1[i]; } }
#pragma unroll
          for (int k = 0; k < 4; ++k) { const int row = crow + 32 * k; const float mu = s_mu[row], rs = s_rs[row]; const v4u x = gvr[k]; v4u o;
              o.x = cvtpk((bflo(x.x) - mu) * rs * lng[0] + lnb[0], (bfhi(x.x) - mu) * rs * lng[1] + lnb[1]); o.y = cvtpk((bflo(x.y) - mu) * rs * lng[2] + lnb[2], (bfhi(x.y) - mu) * rs * lng[3] + lnb[3]);
              o.z = cvtpk((bflo(x.z) - mu) * rs * lng[4] + lnb[4], (bfhi(x.z) - mu) * rs * lng[5] + lnb[5]); o.w = cvtpk((bflo(x.w) - mu) * rs * lng[6] + lnb[6], (bfhi(x.w) - mu) * rs * lng[7] + lnb[7]);
              *(LAS v4u*)(VN + offb(row, cch)) = o; } }
        __syncthreads();
        { bf16x8 va[4];
#pragma unroll
          for (int ks = 0; ks < 4; ++ks) va[ks] = ldtr(VN, tra16(lane, w, ks, 0), tra16(lane, w, ks, 1));
#pragma unroll
          for (int nt = 0; nt < 8; ++nt) { const float bs = s_bsp[16 * nt + l15]; f32x4 acc = (f32x4){bs, bs, bs, bs};
#pragma unroll
              for (int ks = 0; ks < 4; ++ks) if (ks <= nt / 2) acc = __builtin_amdgcn_mfma_f32_16x16x32_bf16(va[ks], ldrow(WC, rra16(lane, nt, ks)), acc, 0, 0, 0);
              *(LAS v2u*)(ZV + zvoff(16 * nt + l15, 2 * w + (g >> 1)) + 8 * (g & 1)) = (v2u){cvtpk(acc[0], acc[1]), cvtpk(acc[2], acc[3])}; } }
        __syncthreads();
#pragma unroll
        for (int k = 0; k < 4; ++k) { const int row = crow + 32 * k; const v4u z = *(const LAS v4u*)(ZV + zvoff(row, cch)), ga = gar[k]; v4u o;
            o.x = cvtpk(bflo(ga.x) * bflo(z.x), bfhi(ga.x) * bfhi(z.x)); o.y = cvtpk(bflo(ga.y) * bflo(z.y), bfhi(ga.y) * bfhi(z.y));
            o.z = cvtpk(bflo(ga.z) * bflo(z.z), bfhi(ga.z) * bfhi(z.z)); o.w = cvtpk(bflo(ga.w) * bflo(z.w), bfhi(ga.w) * bfhi(z.w));
            if (flag) __builtin_amdgcn_raw_buffer_store_b128(o, yrs, (unsigned)(((t0 + row) * D + 128 * gg + 8 * cch) * 2), 0,   16);
            else *(v4u*)(Y + (t0 + row) * D + 128 * gg + 8 * cch) = o; }
        if (flag) { asm volatile("s_waitcnt vmcnt(0)" ::: "memory");
            __syncthreads();
            if (tid == 0) __hip_atomic_store(flag, (unsigned)(ui + 1), RLX_AGENT); }
    }
}
__device__ __forceinline__ void phase_mixa(Frame& F) { mixa_units(F, (int)blockIdx.x & 7, (int)blockIdx.x >> 3, F.G >> 3, (BATCH * (SEQ / 128)) / (F.G >> 3), nullptr); }

constexpr int MC_SP = 0, MC_IV = 32768, MC_QT = 49152, MC_KT = 81920, MC_O = 114688, MC_P = 132096, MC_D = 140288, MC_SQ = 141312, MC_GH = 142336;
__device__ __forceinline__ void moe_weight_copies(Frame& F, int gw, int NGW) {
    const KArgs* ap_ = kargs(); const KArgs& a = *ap_; unsigned char* ws = a.ws;
    LAS float* scr = (LAS float*)(F.lds + F.wave * 16384);
    constexpr int I13 = (D / 64) * (FF / 32), I2 = (FF / 64) * (D / 32);
    const float* w1 = a.in[I_W1]; const float* w3 = a.in[I_W3]; const float* w2 = a.in[I_W2];
    auto dec = [&](int it) -> TrDesc { TrDesc d; const int e = it / (2 * I13 + I2); int r = it % (2 * I13 + I2);
        if (r < 2 * I13) { const int bj = r / I13; r %= I13; const int kb = r / (FF / 32), nb = r % (FF / 32), n0 = 32 * nb;
            d.W = (bj ? w3 : w1) + (size_t)e * D * FF; d.N = FF; d.k0 = 64 * kb; d.n0 = n0; d.WT = (bf16*)(ws + WS_W13) + (size_t)e * D * D; d.Kd = D; d.r0 = 256 * (n0 >> 7) + 128 * bj + (n0 & 127); }
        else { r -= 2 * I13; const int kb = r / (D / 32), nb = r % (D / 32);
            d.W = w2 + (size_t)e * FF * D; d.N = D; d.k0 = 64 * kb; d.n0 = 32 * nb; d.WT = (bf16*)(ws + WS_W2) + (size_t)e * D * FF; d.Kd = FF; d.r0 = 32 * nb; }
        return d; };
    f32x4 tv[8];
    TR_PIPELINE(dec, gw, NGW, NE * (2 * I13 + I2), tv, scr, F.lane, false, true);
}
__device__ __forceinline__ void phase_mixb(Frame& F) {
    if ((int)blockIdx.x >= BATCH * 8) { const int nb = F.G - BATCH * 8, k = (int)blockIdx.x - BATCH * 8;
        const KArgs* ap0_ = kargs(); unsigned* const flag_ = (unsigned*)(ap0_->ws + WS_CTL) + CW_YA + 64 * k;
        if (k < BATCH * 8) mixa_units(F, k & 7, 16 * (k >> 3), 1, SEQ / 128, flag_);
        __syncthreads();
        moe_weight_copies(F, k * NWAVES + F.wave, nb * NWAVES); return; }
    const KArgs* ap_ = kargs(); const KArgs& a = *ap_; unsigned char* ws = a.ws;
    const bf16 *GBOG = (const bf16*)(ws + WS_GBOG), *QS = (const bf16*)(ws + WS_QS), *G = (const bf16*)(ws + WS_G), *IV = (const bf16*)(ws + WS_IV); bf16* Y = (bf16*)(ws + WS_H);
    const int b = (int)blockIdx.x >> 3, h = (int)blockIdx.x & 7, w = F.wave;
    const unsigned lane = F.lane, g = lane >> 4, l15 = lane & 15;
    const bool is_state = w < 4;
    LAS float* const s_d = (LAS float*)(F.lds + MC_D); LAS float* const s_sq = (LAS float*)(F.lds + MC_SQ); LAS float* const s_ghg = (LAS float*)(F.lds + MC_GH);
    LAS unsigned char* const IVI = F.lds + MC_IV; LAS unsigned char* const PB = F.lds + MC_P; LAS unsigned char* const OB = F.lds + MC_O;
    if (F.tid < 128) s_ghg[F.tid] = a.in[I_GHGRN][128 * h + F.tid];
    const size_t tb = (size_t)b * SEQ;
    constexpr int NC = SEQ / 64;
    unsigned* const yaflag = (unsigned*)(ws + WS_CTL) + CW_YA + 64 * (int)blockIdx.x;
    unsigned ya_seen = 0;
#define YA_ENSURE(cs_) do { const unsigned need_ = (unsigned)((cs_) >> 1) + 1u; if (w == 0 && ya_seen < need_) { unsigned v_ = 0; \
        if (lane == 0) { unsigned sp_ = 0; do { v_ = __hip_atomic_load(yaflag, RLX_AGENT); if (v_ >= need_) break; __builtin_amdgcn_s_sleep(8); } while (++sp_ < (1u << 15)); } \
        ya_seen = (unsigned)__builtin_amdgcn_readfirstlane((int)v_); __builtin_amdgcn_fence(__ATOMIC_ACQUIRE, "agent"); asm volatile("s_waitcnt vmcnt(0)" ::: "memory"); } } while (0)
    unsigned ya_v = 0; bool ya_pend = false;
#define YA_ISSUE(cs_) do { const unsigned need_ = (unsigned)((cs_) >> 1) + 1u; ya_pend = (w == 0 && ya_seen < need_); if (ya_pend) ya_v = __hip_atomic_load(yaflag, RLX_AGENT); asm volatile("" ::: "memory"); } while (0)
#define YA_FINISH(cs_) do { if (ya_pend) { const unsigned need_ = (unsigned)((cs_) >> 1) + 1u; unsigned v_ = (unsigned)__builtin_amdgcn_readfirstlane((int)ya_v); \
        if (v_ < need_) { unsigned t_ = v_; if (lane == 0) { unsigned sp_ = 0; do { t_ = __hip_atomic_load(yaflag, RLX_AGENT); if (t_ >= need_) break; __builtin_amdgcn_s_sleep(8); } while (++sp_ < (1u << 15)); } v_ = (unsigned)__builtin_amdgcn_readfirstlane((int)t_); } \
        ya_seen = v_; __builtin_amdgcn_fence(__ATOMIC_ACQUIRE, "agent"); asm volatile("s_waitcnt vmcnt(0)" ::: "memory"); } } while (0)
#define SC_SCORES(pp, q) do { LAS unsigned char* const QT_ = F.lds + MC_QT + (pp) * 16384; LAS unsigned char* const KT_ = F.lds + MC_KT + (pp) * 16384; \
        bf16x8 kf[4]; _Pragma("unroll") for (int ks = 0; ks < 4; ++ks) kf[ks] = ldrow(KT_, rra16(lane, q, ks)); \
        _Pragma("unroll") for (int nt = 0; nt < 4; ++nt) { f32x4 acc = (f32x4){0.f, 0.f, 0.f, 0.f}; \
            if (nt >= q) { bf16x8 qf[4]; _Pragma("unroll") for (int ks = 0; ks < 4; ++ks) qf[ks] = ldrow(QT_, rra16(lane, nt, ks)); \
                _Pragma("unroll") for (int ks = 0; ks < 4; ++ks) acc = __builtin_amdgcn_mfma_f32_16x16x32_bf16(kf[ks], qf[ks], acc, 0, 0, 0); } \
            const int t = 16 * nt + l15, s0 = 16 * q + 4 * g; \
            const float p0 = (s0 + 0 <= t) ? acc[0] : 0.f, p1 = (s0 + 1 <= t) ? acc[1] : 0.f, p2 = (s0 + 2 <= t) ? acc[2] : 0.f, p3 = (s0 + 3 <= t) ? acc[3] : 0.f; \
            *(LAS v2u*)(PB + poff(t, 2 * q + (g >> 1)) + 8 * (g & 1)) = (v2u){cvtpk(p0, p1), cvtpk(p2, p3)}; } } while (0)
    if (!is_state) {
        const int q = w & 3; const unsigned kp = 16 * q + l15, tq = g, st = 64 * q + lane, mrow = st >> 2, mch = 4 * (st & 3);
        const unsigned lGb = 2u * ((((unsigned)tq * 32u + (kp >> 4)) << 9) + 2u * (kp & 15u));
        const unsigned lIb = 2u * (((((unsigned)mrow >> 4) * 32u + (st & 3u)) << 9) + ((unsigned)mrow & 15u) * 32u);
        const unsigned lYb = 2u * ((unsigned)mrow * (unsigned)D + 8u * (unsigned)mch);
#define CH_BLK(p_, cs_) ((const char*)(p_) + 2 * ((((tb >> 4) + 4 * (size_t)(cs_)) * 32 + 4 * (size_t)h) << 9))
#define CH_ROW(p_, cs_) ((const char*)(p_) + 2 * ((tb + 64 * (size_t)(cs_)) * D + 128 * (size_t)h))
        unsigned UA[48], UB[48], V[32];
#define SC_LOAD(U, cs_) do { const char* const gG_ = CH_BLK(G, cs_) + lGb; const char* const gQ_ = CH_BLK(QS, cs_) + lGb; const char* const gI_ = CH_BLK(IV, cs_) + lIb; \
        _Pragma("unroll") for (int i = 0; i < 16; ++i) { U[i] = *(const unsigned*)(gG_ + 64 * i); U[16 + i] = *(const unsigned*)(gQ_ + 64 * i); } \
        _Pragma("unroll") for (int k = 0; k < 4; ++k) { const v4u t_ = *(const v4u*)(gI_ + 16 * k); U[32 + 4 * k] = t_.x; U[33 + 4 * k] = t_.y; U[34 + 4 * k] = t_.z; U[35 + 4 * k] = t_.w; } \
        asm volatile("" ::: "memory"); } while (0)
#define MG_LOAD(cs_) do { const char* const gY_ = CH_ROW(Y, cs_) + lYb; const char* const gB_ = CH_BLK(GBOG, cs_) + lIb; \
        _Pragma("unroll") for (int k = 0; k < 4; ++k) { const v4u ya_ = *(const v4u*)(gY_ + 16 * k), gb_ = *(const v4u*)(gB_ + 16 * k); \
            V[4 * k] = ya_.x; V[4 * k + 1] = ya_.y; V[4 * k + 2] = ya_.z; V[4 * k + 3] = ya_.w; V[16 + 4 * k] = gb_.x; V[17 + 4 * k] = gb_.y; V[18 + 4 * k] = gb_.z; V[19 + 4 * k] = gb_.w; } \
        asm volatile("" ::: "memory"); } while (0)
#define SC_IVIMG(U) do { _Pragma("unroll") for (int k = 0; k < 4; ++k) *(LAS v4u*)(IVI + offb(mrow, mch + k)) = (v4u){U[32 + 4 * k], U[33 + 4 * k], U[34 + 4 * k], U[35 + 4 * k]}; } while (0)
#define SC_SCAN(U, pp) do { float s0_ = 0.f, s1_ = 0.f; _Pragma("unroll") for (int i = 0; i < 16; ++i) { s0_ += bflo(U[i]); s1_ += bfhi(U[i]); } \
        float r0 = 0.f, r1 = 0.f; _Pragma("unroll") for (int j = 1; j < 4; ++j) { const float a0 = __shfl(s0_, (int)(l15 + 16 * j)), a1 = __shfl(s1_, (int)(l15 + 16 * j)); r0 += ((unsigned)j > tq) ? a0 : 0.f; r1 += ((unsigned)j > tq) ? a1 : 0.f; } \
        float E0 = pg8::ex2(r0 * pg8::L2E), E1 = pg8::ex2(r1 * pg8::L2E); unsigned kq_ = kp; asm volatile("" : "+v"(kq_)); const unsigned ab_ = (pp) * 16384 + 4 * (kq_ & 3), kc_ = kq_ >> 2; \
        _Pragma("unroll") for (int i = 15; i >= 0; --i) { const unsigned t = 16 * tq + i; r0 += bflo(U[i]); r1 += bfhi(U[i]); const float n0 = pg8::ex2(r0 * pg8::L2E), n1 = pg8::ex2(r1 * pg8::L2E); \
            const unsigned ad = ab_ + offb(t, kc_); \
            *(LAS unsigned*)(F.lds + MC_QT + ad) = cvtpk(bflo(U[16 + i]) * pg8::rcp(E0), bfhi(U[16 + i]) * pg8::rcp(E1)); *(LAS unsigned*)(F.lds + MC_KT + ad) = cvtpk(E0 - n0, E1 - n1); E0 = n0; E1 = n1; } \
        if (tq == 0) *(LAS f32x2*)(s_d + (pp) * 128 + 2 * kp) = (f32x2){E0, E1}; } while (0)
#define SC_MERGE(c_) do { char* const sY_ = (char*)CH_ROW(Y, c_) + lYb; const f32x4 sq_ = *(const LAS f32x4*)(s_sq + 4 * mrow); \
        const float rstd = __builtin_amdgcn_rsqf(((sq_[0] + sq_[1]) + (sq_[2] + sq_[3])) * (1.f / 128.f) + RMS_EPS); \
        _Pragma("unroll") for (int k = 0; k < 4; ++k) { const v4u o_ = *(const LAS v4u*)(OB + zvoff(mrow, mch + k)); const f32x4 g0 = *(const LAS f32x4*)(s_ghg + 8 * (mch + k)), g1 = *(const LAS f32x4*)(s_ghg + 8 * (mch + k) + 4); v4u y_; \
            y_.x = cvtpk(bflo(V[4 * k]) + bflo(V[16 + 4 * k]) * (bflo(o_.x) * rstd * g0[0]), bfhi(V[4 * k]) + bfhi(V[16 + 4 * k]) * (bfhi(o_.x) * rstd * g0[1])); \
            y_.y = cvtpk(bflo(V[4 * k + 1]) + bflo(V[17 + 4 * k]) * (bflo(o_.y) * rstd * g0[2]), bfhi(V[4 * k + 1]) + bfhi(V[17 + 4 * k]) * (bfhi(o_.y) * rstd * g0[3])); \
            y_.z = cvtpk(bflo(V[4 * k + 2]) + bflo(V[18 + 4 * k]) * (bflo(o_.z) * rstd * g1[0]), bfhi(V[4 * k + 2]) + bfhi(V[18 + 4 * k]) * (bfhi(o_.z) * rstd * g1[1])); \
            y_.w = cvtpk(bflo(V[4 * k + 3]) + bflo(V[19 + 4 * k]) * (bflo(o_.w) * rstd * g1[2]), bfhi(V[4 * k + 3]) + bfhi(V[19 + 4 * k]) * (bfhi(o_.w) * rstd * g1[3])); \
            *(v4u*)(sY_ + 16 * k) = y_; } } while (0)
        SC_LOAD(UA, 0); SC_LOAD(UB, 1); SC_SCAN(UA, 0);
        __syncthreads();
        MG_LOAD(0); SC_IVIMG(UA); SC_LOAD(UA, 2);
        __syncthreads();
        for (int c = 0; c < NC; c += 2) {
            SC_SCAN(UB, 1);
            __syncthreads();
            SC_MERGE(c); MG_LOAD(c + 1); SC_IVIMG(UB); SC_LOAD(UB, min(c + 3, NC - 1));
            __syncthreads();
            SC_SCAN(UA, 0);
            __syncthreads();
            SC_MERGE(c + 1); MG_LOAD(min(c + 2, NC - 1)); SC_IVIMG(UA); SC_LOAD(UA, min(c + 4, NC - 1));
            __syncthreads();
        }
#undef CH_BLK
#undef CH_ROW
#undef SC_LOAD
#undef MG_LOAD
#undef SC_IVIMG
#undef SC_SCAN
#undef SC_MERGE
    } else {
        const int sw = w;
        LAS unsigned char* const SP0 = F.lds + MC_SP + (2 * sw) * 4096;
        f32x4 S[2][8], o[2][4];
#pragma unroll
        for (int j = 0; j < 2; ++j)
#pragma unroll
            for (int c = 0; c < 8; ++c) S[j][c] = (f32x4){0.f, 0.f, 0.f, 0.f};
        unsigned trb[2], trx[2];
#pragma unroll
        for (int t = 0; t < 2; ++t) { const unsigned qq_ = l15 >> 2, p_ = lane & 3, X_ = (qq_ << 2) | ((2 * g + t) & 3); trb[t] = 256u * (8 * g + 4 * t + qq_) + 16u * ((p_ >> 1) ^ (X_ & 1)) + 8u * (p_ & 1); trx[t] = X_ >> 1; }
#define TRA(c_, ks_, t_) (trb[t_] + 8192u * (ks_) + (((unsigned)(c_) ^ trx[t_]) << 5))
#define ST_S1(cn_) do { const int pp_ = (cn_) & 1; LAS unsigned char* const QT_ = F.lds + MC_QT + pp_ * 16384; \
        _Pragma("unroll") for (int hf = 0; hf < 2; ++hf) { f32x4 dv[4]; _Pragma("unroll") for (int cc = 0; cc < 4; ++cc) dv[cc] = *(const LAS f32x4*)(s_d + pp_ * 128 + 16 * (4 * hf + cc) + 4 * g); \
            _Pragma("unroll") for (int j = 0; j < 2; ++j) _Pragma("unroll") for (int cc = 0; cc < 4; ++cc) { const int c8 = 4 * hf + cc; S[j][c8] = S[j][c8] * dv[cc]; \
                *(LAS v2u*)(SP0 + j * 4096 + spoff(l15, 2 * c8 + (g >> 1)) + 8 * (g & 1)) = (v2u){cvtpk(S[j][c8][0], S[j][c8][1]), cvtpk(S[j][c8][2], S[j][c8][3])}; } } \
        bf16x8 sa[2][4]; _Pragma("unroll") for (int j = 0; j < 2; ++j) _Pragma("unroll") for (int ks = 0; ks < 4; ++ks) sa[j][ks] = *(const LAS bf16x8*)(SP0 + j * 4096 + spoff(l15, 4 * ks + g)); \
        _Pragma("unroll") for (int nt = 0; nt < 4; ++nt) { bf16x8 qb[4]; _Pragma("unroll") for (int ks = 0; ks < 4; ++ks) qb[ks] = ldrow(QT_, rra16(lane, nt, ks)); \
            f32x4 a0_ = (f32x4){0.f, 0.f, 0.f, 0.f}, a1_ = (f32x4){0.f, 0.f, 0.f, 0.f}; \
            _Pragma("unroll") for (int ks = 0; ks < 4; ++ks) { a0_ = __builtin_amdgcn_mfma_f32_16x16x32_bf16(sa[0][ks], qb[ks], a0_, 0, 0, 0); a1_ = __builtin_amdgcn_mfma_f32_16x16x32_bf16(sa[1][ks], qb[ks], a1_, 0, 0, 0); } \
            o[0][nt] = a0_; o[1][nt] = a1_; } } while (0)
        YA_ENSURE(0);
        __syncthreads();
        SC_SCORES(0, sw); ST_S1(0);
        __syncthreads();
        for (int c = 0; c < NC; ++c) {
            const int pp = c & 1; LAS unsigned char* const KT = F.lds + MC_KT + pp * 16384;
            asm volatile("" : "+v"(trx[0]), "+v"(trx[1]));
            bf16x8 ivf[2][2];
#pragma unroll
            for (int j = 0; j < 2; ++j)
#pragma unroll
                for (int ks = 0; ks < 2; ++ks) ivf[j][ks] = ldtr(IVI, TRA(2 * sw + j, ks, 0), TRA(2 * sw + j, ks, 1));
#pragma unroll
            for (int nt = 0; nt < 4; ++nt) { bf16x8 pb[2];
#pragma unroll
                for (int ks = 0; ks < 2; ++ks) if (2 * ks <= nt) pb[ks] = *(const LAS bf16x8*)(PB + poff(16 * nt + l15, 4 * ks + g));
#pragma unroll
                for (int ks = 0; ks < 2; ++ks) if (2 * ks <= nt) { o[0][nt] = __builtin_amdgcn_mfma_f32_16x16x32_bf16(ivf[0][ks], pb[ks], o[0][nt], 0, 0, 0); o[1][nt] = __builtin_amdgcn_mfma_f32_16x16x32_bf16(ivf[1][ks], pb[ks], o[1][nt], 0, 0, 0); } }
#pragma unroll
            for (int cc = 0; cc < 8; ++cc) { bf16x8 ka[2];
#pragma unroll
                for (int ks = 0; ks < 2; ++ks) ka[ks] = ldtr(KT, TRA(cc, ks, 0), TRA(cc, ks, 1));
#pragma unroll
                for (int ks = 0; ks < 2; ++ks)
#pragma unroll
                    for (int j = 0; j < 2; ++j) S[j][cc] = __builtin_amdgcn_mfma_f32_16x16x32_bf16(ka[ks], ivf[j][ks], S[j][cc], 0, 0, 0); }
#pragma unroll
            for (int nt = 0; nt < 4; ++nt) { float qs = 0.f;
#pragma unroll
                for (int j = 0; j < 2; ++j) { qs += (o[j][nt][0] * o[j][nt][0] + o[j][nt][1] * o[j][nt][1]) + (o[j][nt][2] * o[j][nt][2] + o[j][nt][3] * o[j][nt][3]);
                    *(LAS v2u*)(OB + zvoff(16 * nt + l15, 4 * sw + 2 * j + (g >> 1)) + 8 * (g & 1)) = (v2u){cvtpk(o[j][nt][0], o[j][nt][1]), cvtpk(o[j][nt][2], o[j][nt][3])}; }
                qs += __shfl_xor(qs, 16); qs += __shfl_xor(qs, 32); if (g == 0) s_sq[(16 * nt + l15) * 4 + sw] = qs; }
            __syncthreads();
            YA_ISSUE(min(c + 2, NC - 1));
            if (c + 1 < NC) { SC_SCORES((c + 1) & 1, sw); ST_S1(c + 1); }
            YA_FINISH(min(c + 2, NC - 1));
            __syncthreads();
        }
#undef ST_S1
#undef YA_ENSURE
#undef YA_ISSUE
#undef YA_FINISH
#undef SC_SCORES
#undef TRA
    }
}

typedef int v2i __attribute__((ext_vector_type(2)));
typedef float v2f __attribute__((ext_vector_type(2)));
__device__ __forceinline__ void phase_final(Frame& F) {
    const KArgs* ap_ = kargs(); const KArgs& a = *ap_; unsigned char* ws = a.ws;
    const float* ada = (const float*)(ws + WS_ADA); const float* gp = a.in[I_GPOSTFFN];
    const int* POS = (const int*)(ws + WS_RANK); const int* EID = (const int*)(ws + WS_EID); const LAS int* s_offs = (const LAS int*)(F.lds + 131072 + 512); const float* EW = (const float*)(ws + WS_EW); const bf16* OUTP = (const bf16*)(ws + WS_OUTP); const bf16* X1B = (const bf16*)(ws + WS_X1);
    const int rows_per = T / F.G, row0 = (int)blockIdx.x * rows_per;
    constexpr int R = 2;
    f32x4 ggt[4];
    { const float* ab = ada + (size_t)(row0 / SEQ) * 6144;
#pragma unroll
      for (int j = 0; j < 4; ++j) { const int c = 256 * j + 4 * F.lane; ggt[j] = *(const f32x4*)(gp + c) * *(const f32x4*)(ab + 5 * D + c); } }
    v2i pp[R], ee[R]; v2f ww[R], cw[R]; v2u u0[R][4], u1[R][4], xb[R][4];
#define FN_POS(i0_) do { _Pragma("unroll") for (int r = 0; r < R; ++r) { const int m = row0 + (i0_) + r * NWAVES; pp[r] = *(const v2i*)(POS + 2 * m); ee[r] = *(const v2i*)(EID + 2 * m); ww[r] = *(const v2f*)(EW + 2 * m); } asm volatile("" ::: "memory"); } while (0)
#define FN_ROWS(i0_) do { _Pragma("unroll") for (int r = 0; r < R; ++r) { const int m = row0 + (i0_) + r * NWAVES; \
            const v2u* r0 = (const v2u*)(OUTP + (size_t)(pp[r].x + s_offs[ee[r].x]) * D) + F.lane; const v2u* r1 = (const v2u*)(OUTP + (size_t)(pp[r].y + s_offs[ee[r].y]) * D) + F.lane; const v2u* xrow = (const v2u*)(X1B + (size_t)m * D) + F.lane; \
            _Pragma("unroll") for (int j = 0; j < 4; ++j) { u0[r][j] = r0[64 * j]; u1[r][j] = r1[64 * j]; xb[r][j] = xrow[64 * j]; } cw[r] = ww[r]; } asm volatile("" ::: "memory"); } while (0)
    const int step = R * NWAVES;
    FN_POS(F.wave); FN_ROWS(F.wave);
    FN_POS((F.wave + step < rows_per) ? F.wave + step : F.wave);
    for (int i0 = F.wave; i0 < rows_per; i0 += step) {
        const int i1 = (i0 + step < rows_per) ? i0 + step : i0, i2 = (i1 + step < rows_per) ? i1 + step : i1;
        f32x4 y[R][4], xo[R][4]; float s[R];
#pragma unroll
        for (int r = 0; r < R; ++r) { float t = 0.f; const float w0 = cw[r].x, w1 = cw[r].y;
#pragma unroll
            for (int j = 0; j < 4; ++j) { const v2u a0 = u0[r][j], a1 = u1[r][j], xx = xb[r][j];
                y[r][j].x = w0 * bf2f(a0.x & 0xffffu) + w1 * bf2f(a1.x & 0xffffu); y[r][j].y = w0 * bf2f(a0.x >> 16) + w1 * bf2f(a1.x >> 16);
                y[r][j].z = w0 * bf2f(a0.y & 0xffffu) + w1 * bf2f(a1.y & 0xffffu); y[r][j].w = w0 * bf2f(a0.y >> 16) + w1 * bf2f(a1.y >> 16);
                xo[r][j] = (f32x4){bf2f(xx.x & 0xffffu), bf2f(xx.x >> 16), bf2f(xx.y & 0xffffu), bf2f(xx.y >> 16)};
                t += (y[r][j].x * y[r][j].x + y[r][j].y * y[r][j].y) + (y[r][j].z * y[r][j].z + y[r][j].w * y[r][j].w); }
            s[r] = t; }
        FN_ROWS(i1);
        FN_POS(i2);
#pragma unroll
        for (int o = 1; o < 64; o <<= 1) {
#pragma unroll
            for (int r = 0; r < R; ++r) s[r] += __shfl_xor(s[r], o); }
#pragma unroll
        for (int r = 0; r < R; ++r) { const int m = row0 + i0 + r * NWAVES;
            const float rr = __builtin_amdgcn_rsqf(s[r] * (1.f / D) + RMS_EPS);
            f32x4* orow = (f32x4*)(a.out + (size_t)m * D) + F.lane;
#pragma unroll
            for (int j = 0; j < 4; ++j) __builtin_nontemporal_store(xo[r][j] + ggt[j] * (y[r][j] * rr), orow + 64 * j); }
    }
#undef FN_POS
#undef FN_ROWS
}

__global__ void __launch_bounds__(NTHREADS, 2) mega(Args args) {
    extern __shared__ __attribute__((aligned(16))) unsigned char lds[];
    Frame F; F.lds = (LAS unsigned char*)lds; F.tid = threadIdx.x; F.lane = F.tid & 63; F.wave = __builtin_amdgcn_readfirstlane(F.tid >> 6);
    F.G = gridDim.x; { const int bx = blockIdx.x; F.vcu = (F.G % 8 == 0) ? (bx % 8) * (F.G / 8) + bx / 8 : bx; }
    volatile LAS unsigned* MISC = (volatile LAS unsigned*)(F.lds + MISC_OFF);
    for (int u = F.tid; u < (LDS_BYTES - 131072) / 4; u += NTHREADS) ((LAS unsigned*)(F.lds + 131072))[u] = 0u;
    __syncthreads();
    XcdBarrier bar = xcd_barrier_post((unsigned*)(args.ws + WS_CTL) + CW_BAR + args.li * XCD_BAR_WORDS, MISC + 8);
    const int lo = args.ph_lo, hi = args.ph_hi;
#define IN(k) (lo <= (k) && (k) < hi)
#define SEAM(k) do { if (IN(k) && IN((k) + 1)) xcd_barrier(bar); } while (0)
#ifndef PROBE_MASK
#define PROBE_MASK 0
#endif
#ifndef PROBE_REPS
#define PROBE_REPS 2
#endif
#define REPS(k) for (int rep_ = 0; rep_ < (((PROBE_MASK >> (k)) & 1) ? PROBE_REPS : 1); ++rep_, (void)((((PROBE_MASK >> (k)) & 1) && rep_ < PROBE_REPS) ? (xcd_barrier(bar), 0) : 0))
    if (IN(PH_PREP)) REPS(PH_PREP) { phase_prep(F); } SEAM(PH_PREP);
    if (IN(PH_HNORM)) REPS(PH_HNORM) { phase_hnorm(F); } SEAM(PH_HNORM);
    unsigned char* const ws = args.ws;
    if (IN(PH_INPROJ)) REPS(PH_INPROJ) {
        pg8::Gemm g{(const bf16*)(ws + WS_H), (const bf16*)(ws + WS_WIN), T, NIN, D}; pg8::TableOrder<pg8::StaticOrder> S; S.init(T, NIN, F.G, (int)blockIdx.x);
        { LAS pg8::pg8_i4* tab = (LAS pg8::pg8_i4*)(F.lds + 147456); S.fill(tab, 32); __syncthreads(); S.finish(tab, 32); }
        pg8::EpiInproj E{(bf16*)(ws + WS_GAU), (bf16*)(ws + WS_GBOG), (bf16*)(ws + WS_GV), (bf16*)(ws + WS_QS), (bf16*)(ws + WS_G), (bf16*)(ws + WS_IV), (float*)(ws + WS_VSTAT), (const float*)(ws + WS_LBV)};
        pg8::gemm_phase<pg8::EpiInproj, pg8::TableOrder<pg8::StaticOrder>, true, true>(F.lds, g, S, E);
    } SEAM(PH_INPROJ);
    if (IN(PH_MIXB)) REPS(PH_MIXB) { phase_mixb(F); } SEAM(PH_MIXB);
    if (IN(PH_OUTPROJ)) REPS(PH_OUTPROJ) {
        pg8::Gemm g{(const bf16*)(ws + WS_H), (const bf16*)(ws + WS_WOUT), T, D, D}; pg8::StaticOrder S; S.init(T, D, F.G, (int)blockIdx.x);
        pg8::EpiBf16 E{(bf16*)(ws + WS_Y2), D};
        pg8::gemm_phase<pg8::EpiBf16, pg8::StaticOrder, true, true>(F.lds, g, S, E);
    } SEAM(PH_OUTPROJ);
    if (IN(PH_ROW1)) REPS(PH_ROW1) { phase_row1(F); } SEAM(PH_ROW1);
    LAS int* s_offs = (LAS int*)(F.lds + 131072 + 512);
    LAS int* s_tot = s_offs + 32;
    if (IN(PH_MOE1) || IN(PH_MOE2) || IN(PH_FINAL)) {
        if (F.tid < NE) s_tot[F.tid] = (int)__hip_atomic_load((unsigned*)(ws + WS_CTL) + CW_TOT + 64 * F.tid, RLX_AGENT);
        __syncthreads();
        if (F.tid == 0) { int o = 0; for (int e = 0; e < NE; ++e) { s_offs[e] = o; o += (s_tot[e] + 255) & ~255; } s_offs[NE] = o; }
        __syncthreads(); }
    unsigned* const pcnt = (unsigned*)(ws + WS_CTL) + CW_PANEL;
    if (IN(PH_MOE1)) {
        pg8::TableOrder<pg8::GroupedSignal> S; S.init(s_offs, D, F.G, (int)blockIdx.x); S.cnt = pcnt;
        { LAS pg8::pg8_i4* tab = (LAS pg8::pg8_i4*)(F.lds + 147456); S.fill(tab, 8); __syncthreads(); S.finish(tab, 8); }
        LAS int* s_idx = (LAS int*)(F.lds + 133120);
        { const int* IDXREL = (const int*)(ws + WS_IDXREL);
          int tok[3]; bool have[3];
#pragma unroll
          for (int k = 0; k < 3; ++k) { pg8::Unit u; const int i = 2 * k + (int)(F.tid >> 8); have[k] = S.next(i, u); tok[k] = 0;
              if (have[k]) { const int e = u.pnb / (D / 256), lr = u.pm * 256 - s_offs[e] + (int)(F.tid & 255); if (lr < s_tot[e]) tok[k] = IDXREL[e * 65536 + lr]; } }
#pragma unroll
          for (int k = 0; k < 3; ++k) if (have[k]) s_idx[(2 * k + (int)(F.tid >> 8)) * 256 + (F.tid & 255)] = tok[k];
          __syncthreads(); }
        pg8::Gemm g{(const bf16*)(ws + WS_H2), (const bf16*)(ws + WS_W13), NPMAX, D, D, s_idx};
        pg8::EpiMoe1 E{(bf16*)(ws + WS_ACT), NPMAX * FF * 2};
        pg8::gemm_phase<pg8::EpiMoe1, pg8::TableOrder<pg8::GroupedSignal>, true, true, true>(F.lds, g, S, E);
    }
    if (IN(PH_MOE1) && !IN(PH_MOE2)) xcd_barrier(bar);
    if (IN(PH_MOE2)) {
        pg8::Gemm g{(const bf16*)(ws + WS_ACT), (const bf16*)(ws + WS_W2), NPMAX, D, FF}; pg8::GroupedWait S; S.init(s_offs, D, F.G, F.G - 1 - (int)blockIdx.x); S.cnt = pcnt; S.need = 8u * (D / 256);
        S.qcnt = (unsigned*)(ws + WS_CTL) + CW_QUEUE; S.xcd = (int)(xb_xcc_id() & 7u); S.slot = (LAS int*)(F.lds + 131072 + 128);
        pg8::EpiBf16 E{(bf16*)(ws + WS_OUTP), D};
        pg8::gemm_phase<pg8::EpiBf16, pg8::GroupedWait, true, true>(F.lds, g, S, E);
    } SEAM(PH_MOE2);
    if (IN(PH_FINAL)) { phase_final(F); }
#undef IN
#undef SEAM
}

template <class Epi, bool PAIRED>
__global__ void __launch_bounds__(256) naive_gemm(const bf16* __restrict__ A, const bf16* __restrict__ Bt, int K, int ntn, const int* __restrict__ offs, size_t estride, Epi E) {
    __shared__ __attribute__((aligned(16))) bf16 sA[64 * 40], sB0[64 * 40], sB1[64 * 40];
    const int bx = blockIdx.x % ntn, by = blockIdx.x / ntn, m0 = by * 64;
    const bf16* Bb = Bt;
    if (offs) { if (m0 >= offs[NE]) return; int e = 0; while (m0 >= offs[e + 1]) ++e; Bb += (size_t)e * estride; }
    int n0a, n0b = 0, pn = 0, cc0 = 0;
    if (PAIRED) { pn = bx >> 1; cc0 = (bx & 1) * 64; n0a = 256 * pn + cc0; n0b = n0a + 128; } else n0a = bx * 64;
    const int tid = threadIdx.x, lane = tid & 63, w = tid >> 6, lr = tid >> 2, lc = (tid & 3) * 8;
    f32x4 acc0[4], acc1[4];
#pragma unroll
    for (int n = 0; n < 4; ++n) { acc0[n] = (f32x4){0.f, 0.f, 0.f, 0.f}; acc1[n] = (f32x4){0.f, 0.f, 0.f, 0.f}; }
    for (int k0 = 0; k0 < K; k0 += 32) {
        *(v4u*)&sA[lr * 40 + lc] = *(const v4u*)&A[(size_t)(m0 + lr) * K + k0 + lc];
        *(v4u*)&sB0[lr * 40 + lc] = *(const v4u*)&Bb[(size_t)(n0a + lr) * K + k0 + lc];
        if (PAIRED) *(v4u*)&sB1[lr * 40 + lc] = *(const v4u*)&Bb[(size_t)(n0b + lr) * K + k0 + lc];
        __syncthreads();
        const bf16x8 av = *(const bf16x8*)&sA[(16 * w + (lane & 15)) * 40 + 8 * (lane >> 4)];
#pragma unroll
        for (int n = 0; n < 4; ++n) {
            const bf16x8 b0 = *(const bf16x8*)&sB0[(16 * n + (lane & 15)) * 40 + 8 * (lane >> 4)];
            acc0[n] = __builtin_amdgcn_mfma_f32_16x16x32_bf16(av, b0, acc0[n], 0, 0, 0);
            if (PAIRED) { const bf16x8 b1 = *(const bf16x8*)&sB1[(16 * n + (lane & 15)) * 40 + 8 * (lane >> 4)];
                acc1[n] = __builtin_amdgcn_mfma_f32_16x16x32_bf16(av, b1, acc1[n], 0, 0, 0); }
        }
        __syncthreads();
    }
#pragma unroll
    for (int n = 0; n < 4; ++n)
#pragma unroll
        for (int r = 0; r < 4; ++r) { const int row = m0 + 16 * w + 4 * (lane >> 4) + r, cin = 16 * n + (lane & 15);
            if (PAIRED) E.pair(row, pn, cc0 + cin, acc0[n][r], acc1[n][r]); else E.one(row, n0a + cin, acc0[n][r]); }
}
struct EpiInprojN { bf16 *GAU, *GBOG, *GV, *QS, *G, *IV; const float* lbv;
    __device__ __forceinline__ void pair(int row, int pn, int cc, float v0, float v1) const {
        const int j = pn >> 2, type = pn & 3, col = 128 * j + cc; const size_t idx = (size_t)row * D + col;
        if (type == 0) GAU[idx] = (bf16)f2bf(gelu_f(v0) * sigmoid_f(v1));
        else if (type == 1) GBOG[idx] = (bf16)f2bf(silu_f(v0) * sigmoid_f(v1));
        else if (type == 2) { GV[idx] = (bf16)f2bf(gelu_f(v0)); QS[idx] = (bf16)f2bf(silu_f(v1)); }
        else { const float lb = lbv[col]; G[idx] = (bf16)f2bf(logf(lb + (1.0f - lb) * sigmoid_f(v0))); IV[idx] = (bf16)f2bf(v1); }
    }
    __device__ __forceinline__ void one(int, int, float) const {}
};
struct EpiF32N { float* C; __device__ __forceinline__ void one(int row, int col, float v) const { C[(size_t)row * D + col] = v; } __device__ __forceinline__ void pair(int, int, int, float, float) const {} };
struct EpiMoe1N { bf16* ACT; __device__ __forceinline__ void pair(int row, int pn, int cc, float v0, float v1) const { ACT[(size_t)row * FF + 128 * pn + cc] = (bf16)f2bf(silu_f(v0) * v1); } __device__ __forceinline__ void one(int, int, float) const {} };
struct EpiBf16N { bf16* C; __device__ __forceinline__ void one(int row, int col, float v) const { C[(size_t)row * D + col] = (bf16)f2bf(v); } __device__ __forceinline__ void pair(int, int, int, float, float) const {} };

__global__ void __launch_bounds__(256) naive_vstat(const bf16* __restrict__ GV, float* __restrict__ VSTAT) {
    const int row = blockIdx.x * 4 + (threadIdx.x >> 6), lane = threadIdx.x & 63;
    float s = 0.f, ss = 0.f;
    for (int c = lane; c < D; c += 64) { const float v = bf2f(GV[(size_t)row * D + c]); s += v; ss += v * v; }
    s = wave_sum(s); ss = wave_sum(ss);
    if (lane < 32) { float* p = VSTAT + ((size_t)row * 32 + lane) * 2; p[0] = lane == 0 ? s : 0.f; p[1] = lane == 0 ? ss : 0.f; }
}

__global__ void __launch_bounds__(256) naive_mixer(Args a) {
    extern __shared__ __attribute__((aligned(16))) unsigned char lds[];
    float* s_vn = (float*)lds;
    float* s_zv = s_vn + 128 * 128;
    float* s_f = s_zv + 128 * 128;
    float* s_op = s_f + 384;
    float* s_red = s_op + 256;
    float* s_mu = s_red + 4;
    unsigned char* ws = a.ws;
    const bf16 *GAU = (const bf16*)(ws + WS_GAU), *GBOG = (const bf16*)(ws + WS_GBOG), *GV = (const bf16*)(ws + WS_GV), *QS = (const bf16*)(ws + WS_QS), *G = (const bf16*)(ws + WS_G), *IV = (const bf16*)(ws + WS_IV);
    const float* VSTAT = (const float*)(ws + WS_VSTAT); bf16* Y = (bf16*)(ws + WS_H);
    const int b = blockIdx.x >> 3, h = blockIdx.x & 7, tid = threadIdx.x, v = tid & 127, kh = tid >> 7, ch = 128 * h + v;
    const float* Wsp = a.in[I_WSP] + (size_t)h * 128 * 128; const float* bsp = a.in[I_BSP] + h * 128;
    const float lng = a.in[I_LNVG][ch], lnb = a.in[I_LNVB][ch], ghg = a.in[I_GHGRN][ch];
    float S[64];
#pragma unroll
    for (int i = 0; i < 64; ++i) S[i] = 0.f;
    for (int n = 0; n < SEQ / 128; ++n) {
        const size_t t0 = (size_t)b * SEQ + 128 * n;
        __syncthreads();
        if (tid < 128) { const float* p = VSTAT + (t0 + tid) * 64; float s = 0.f, ss = 0.f; for (int q = 0; q < 32; ++q) { s += p[2 * q]; ss += p[2 * q + 1]; }
            const float mu = s * (1.f / D), var = ss * (1.f / D) - mu * mu; s_mu[tid] = mu; s_mu[128 + tid] = 1.0f / sqrtf(var + LN_EPS); }
        __syncthreads();
        for (int s = kh; s < 128; s += 2) s_vn[s * 128 + v] = (bf2f(GV[(t0 + s) * D + ch]) - s_mu[s]) * s_mu[128 + s] * lng + lnb;
        __syncthreads();
        for (int t = kh; t < 128; t += 2) { float acc = bsp[t]; const float* wr = Wsp + t * 128;
            for (int s = 0; s <= t; ++s) acc += wr[s] * s_vn[s * 128 + v];
            s_zv[t * 128 + v] = acc; }
        __syncthreads();
        for (int tok = 0; tok < 128; ++tok) {
            const size_t tg = t0 + tok;
            if (tid < 128) { const float f = __expf(bf2f(G[tg * D + ch])); s_f[tid] = f; s_f[128 + tid] = 1.0f - f; s_f[256 + tid] = bf2f(QS[tg * D + ch]); }
            __syncthreads();
            const float iv = bf2f(IV[tg * D + ch]); float part = 0.f;
#pragma unroll
            for (int i = 0; i < 64; ++i) { const int k = 64 * kh + i; S[i] = s_f[k] * S[i] + s_f[128 + k] * iv; part += s_f[256 + k] * S[i]; }
            s_op[kh * 128 + v] = part;
            __syncthreads();
            float o = 0.f;
            if (tid < 128) { o = s_op[v] + s_op[128 + v]; const float sq = wave_sum(o * o); if ((tid & 63) == 0) s_red[tid >> 6] = sq; }
            __syncthreads();
            if (tid < 128) { const float rstd = 1.0f / sqrtf((s_red[0] + s_red[1]) * (1.f / 128.f) + RMS_EPS);
                const float y = bf2f(GAU[tg * D + ch]) * s_zv[tok * 128 + v] + bf2f(GBOG[tg * D + ch]) * (o * rstd * ghg);
                Y[tg * D + ch] = (bf16)f2bf(y); }
        }
    }
}

extern "C" void kernel_launch(void* const* d_in, const int* in_sizes, int n_in, void* d_out, int out_size, void* d_ws, size_t ws_size, hipStream_t stream) {
    static int grid = 0;
    if (grid == 0) {
        if (n_in != 23 || in_sizes[0] != T * D || out_size != T * D || ws_size < WS_END) { fprintf(stderr, "kernel_launch: unexpected shapes / workspace (n_in %d, in0 %d, out %d, ws %zu)\n", n_in, n_in > 0 ? in_sizes[0] : -1, out_size, ws_size); grid = -1; return; }
        int dev = 0, cus = 0;
        if (hipGetDevice(&dev) != hipSuccess || hipDeviceGetAttribute(&cus, hipDeviceAttributeMultiprocessorCount, dev) != hipSuccess) { grid = -1; return; }
        if (hipFuncSetAttribute((const void*)mega, hipFuncAttributeMaxDynamicSharedMemorySize, LDS_BYTES) != hipSuccess) { fprintf(stderr, "kernel_launch: hipFuncSetAttribute(mega) failed\n"); grid = -1; return; }
        if (hipFuncSetAttribute((const void*)naive_mixer, hipFuncAttributeMaxDynamicSharedMemorySize, 140000) != hipSuccess) { fprintf(stderr, "kernel_launch: hipFuncSetAttribute(naive_mixer) failed\n"); grid = -1; return; }
        (void)hipGetLastError();
        grid = cus;
        if (grid != 256) fprintf(stderr, "kernel_launch: %d CUs (built for 256)\n", grid);
    }
    if (grid < 0) return;
    (void)hipMemsetAsync((char*)d_ws + WS_CTL, 0, CTL_ZERO_BYTES, stream);
    Args a{};
    for (int i = 0; i < 23; ++i) a.in[i] = (const float*)d_in[i];
    a.out = (float*)d_out; a.ws = (unsigned char*)d_ws;
    unsigned char* ws = (unsigned char*)d_ws;
    int li = 0;
    auto run = [&](int lo, int hi) { a.ph_lo = lo; a.ph_hi = hi; a.li = li++; hipLaunchKernelGGL(mega, dim3(grid), dim3(NTHREADS), LDS_BYTES, stream, a); };
    run(PH_PREP, PH_N);
}
```

```cpp
#include <hip/hip_runtime.h>
#include <cstdio>
#include <cstdint>

#define GAS __attribute__((address_space(1)))
#define LAS __attribute__((address_space(3)))
typedef unsigned short bf16;
typedef unsigned v4u __attribute__((ext_vector_type(4)));
typedef unsigned v2u __attribute__((ext_vector_type(2)));
typedef float f32x4 __attribute__((ext_vector_type(4)));
typedef float f32x2 __attribute__((ext_vector_type(2)));
typedef short bf16x8 __attribute__((ext_vector_type(8)));
typedef GAS unsigned gu32;

constexpr int D = 1024, BATCH = 16, SEQ = 2048, T = BATCH * SEQ, NIN = 8 * D, NE = 16, FF = 512;
constexpr int NPMAX = 69632;
constexpr float RMS_EPS = 1e-6f, LN_EPS = 1e-5f;
constexpr int NWAVES = 8, NTHREADS = 512;

constexpr size_t MiB = 1u << 20;
constexpr size_t WS_CTL = 0, CTL_ZERO_BYTES = 1 * MiB;
constexpr size_t WS_ADA = 1 * MiB;
constexpr size_t WS_LBV = 2 * MiB;
constexpr size_t WS_CNT = 2 * MiB + 64 * 1024;
constexpr size_t WS_OFFS = 2 * MiB + 96 * 1024;
constexpr size_t WS_EID = 2 * MiB + 128 * 1024;
constexpr size_t WS_EW = WS_EID + 256 * 1024;
constexpr size_t WS_RANK = WS_EW + 256 * 1024;
constexpr size_t WS_POS = WS_RANK + 256 * 1024;
constexpr size_t WS_IDX = 3 * MiB + 256 * 1024;
constexpr size_t WS_VSTAT = 4 * MiB;
constexpr size_t WS_IDXREL = 4 * MiB;
constexpr int CW_QUEUE = 61440;
constexpr int CW_PANEL = 32768;
constexpr int CW_TOT = 2048;
constexpr size_t WS_WIN = 12 * MiB;
constexpr size_t WS_WOUT = 28 * MiB;
constexpr size_t WS_H = 32 * MiB;
constexpr size_t WS_GAU = 96 * MiB, WS_GBOG = 160 * MiB, WS_GV = 224 * MiB, WS_QS = 288 * MiB, WS_G = 352 * MiB, WS_IV = 416 * MiB;
constexpr size_t WS_Y2 = 96 * MiB;
constexpr size_t WS_X1 = 336 * MiB;
constexpr size_t WS_H2 = 400 * MiB;
constexpr size_t WS_W13 = 480 * MiB;
constexpr size_t WS_W2 = 12 * MiB;
constexpr size_t WS_H2P = 336 * MiB;
constexpr size_t WS_ACT = 96 * MiB;
constexpr size_t WS_OUTP = 164 * MiB;
constexpr size_t WS_END = 512 * MiB;

constexpr int LDS_BYTES = 155648;
constexpr int MISC_OFF = 131072 + 320;

#define RLX_AGENT __ATOMIC_RELAXED, __HIP_MEMORY_SCOPE_AGENT
#define LDS_WAIT() asm volatile("s_waitcnt lgkmcnt(0)" ::: "memory")
__device__ __forceinline__ unsigned f2bf(float f) { unsigned u = __builtin_bit_cast(unsigned, f); return (u + 0x7fffu + ((u >> 16) & 1u)) >> 16; }
typedef __bf16 bf16x2_hw __attribute__((ext_vector_type(2)));
typedef float f32x2_hw __attribute__((ext_vector_type(2)));
__device__ __forceinline__ unsigned pk2(float lo, float hi) { const f32x2_hw v = {lo, hi}; return __builtin_bit_cast(unsigned, __builtin_convertvector(v, bf16x2_hw)); }
__device__ __forceinline__ float bf2f(unsigned b) { return __builtin_bit_cast(float, b << 16); }
__device__ __forceinline__ float sigmoid_f(float z) { return 1.0f / (1.0f + __expf(-z)); }
__device__ __forceinline__ float gelu_f(float x) { return x * sigmoid_f(1.5957691216057308f * (x + 0.044715f * x * x * x)); }
__device__ __forceinline__ float silu_f(float x) { return x * sigmoid_f(x); }
__device__ __forceinline__ float wave_sum(float v) {
#pragma unroll
    for (int o = 1; o < 64; o <<= 1) v += __shfl_xor(v, o);
    return v;
}

namespace pg8 {
#define PG8_LAS __attribute__((address_space(3)))
typedef unsigned short bf16_t;
typedef short bf16x8 __attribute__((ext_vector_type(8)));
typedef float f32x4 __attribute__((ext_vector_type(4)));
typedef unsigned u32x4 __attribute__((ext_vector_type(4)));
constexpr int BM = 256, BK = 64, HALF = 128, HTB = HALF * BK * 2  , STAGE_BYTES = 8 * HTB, NXCD = 8, WGM = 8;

__host__ __device__ __forceinline__ int lds_byte(int r, int c) { const int st = (r >> 4) * 2 + (c >> 5), rr = r & 15, cc = c & 31, ob = rr * 64 + cc * 2; return st * 1024 + (ob ^ (((ob >> 9) & 1) << 5)); }
__host__ __device__ __forceinline__ void stage_rc(int b, int& R, int& C) { const int st = b / 1024, sb = b % 1024, swz = sb ^ (((sb >> 9) & 1) << 5); R = (st >> 1) * 16 + swz / 64; C = (st & 1) * 32 + (swz % 64) / 2; }
__host__ __device__ __forceinline__ int perm32(int rho) { const int n = rho >> 4, i = rho & 15; return 8 * (i >> 2) + 4 * n + (i & 3); }

struct Unit { int pm, pn, pnb; };
struct Gemm { const bf16_t* A; const bf16_t* Bt; int M, N, K; const PG8_LAS int* sidx; };

struct StaticOrder {
    int nM, nN, nwg, G, c;
    __host__ __device__ void init(int M, int N, int G_, int c_) { nM = M / BM; nN = N / BM; nwg = nM * nN; G = G_; c = c_; }
    __host__ __device__ bool next(int i, Unit& u) const {
        const long L = (long)i * G + c; if (L >= nwg) return false;
        int wgid = (int)L; { const int q = nwg / NXCD, r = nwg % NXCD, xcd = wgid % NXCD, off = wgid / NXCD; wgid = (xcd < r ? xcd * (q + 1) : r * (q + 1) + (xcd - r) * q) + off; }
        const int nig = WGM * nN, gid = wgid / nig, fm = gid * WGM, gsz = (nM - fm) < WGM ? (nM - fm) : WGM;
        u.pm = fm + ((wgid % nig) % gsz); u.pn = (wgid % nig) / gsz; u.pnb = u.pn; return true;
    }
    __device__ __forceinline__ void a_ready(const Unit&) const {}
    __device__ __forceinline__ void done(const Unit&) const {}
    __device__ __forceinline__ void done_deferred(const Unit&) const {}
};

typedef float f32x2 __attribute__((ext_vector_type(2)));

typedef __bf16 bf16x2_t __attribute__((ext_vector_type(2)));
__device__ __forceinline__ unsigned cvt_pk_bf16(float lo, float hi) { const f32x2 v = {lo, hi}; const bf16x2_t b = __builtin_convertvector(v, bf16x2_t); return __builtin_bit_cast(unsigned, b); }
__device__ __forceinline__ float ex2(float x) { return __builtin_amdgcn_exp2f(x); }
__device__ __forceinline__ float rcp(float x) { return __builtin_amdgcn_rcpf(x); }
constexpr float L2E = 1.4426950408889634f, GK = 1.5957691216057308f * 1.4426950408889634f;
__device__ __forceinline__ float gelu_arg(float x) { return -GK * (x + 0.044715f * x * x * x); }
__device__ __forceinline__ u32x4 pack8(const float (&o)[8]) { u32x4 w; w.x = cvt_pk_bf16(o[0], o[1]); w.y = cvt_pk_bf16(o[2], o[3]); w.z = cvt_pk_bf16(o[4], o[5]); w.w = cvt_pk_bf16(o[6], o[7]); return w; }

struct EpiInproj {
    static constexpr bool PERM = true, AFTER_DRAIN = false;
    bf16_t *GAU, *GBOG, *GV, *QS, *G, *IV; float* VSTAT; const float* lbv;
    __device__ __forceinline__ void operator()(const f32x4 (&acc)[2][2][4][2], const Unit& u, int wr, int wc, int fr, int fq) const {
        const int j = u.pn >> 2, type = u.pn & 3, row0 = u.pm * BM + wr * 64 + fr, col0 = 128 * j + wc * 32 + 8 * fq;
        float lb[8];
        if (type == 3) { const f32x4 l0 = *(const f32x4*)(lbv + col0), l1 = *(const f32x4*)(lbv + col0 + 4); lb[0] = l0[0]; lb[1] = l0[1]; lb[2] = l0[2]; lb[3] = l0[3]; lb[4] = l1[0]; lb[5] = l1[1]; lb[6] = l1[2]; lb[7] = l1[3]; }
        else {
#pragma unroll
            for (int i = 0; i < 8; ++i) lb[i] = 0.f; }
#pragma unroll
        for (int ai = 0; ai < 2; ++ai)
#pragma unroll
            for (int m = 0; m < 4; ++m) {
                const int row = row0 + ai * HALF + m * 16; const size_t off = ((size_t)(row >> 4) * 32 + (col0 >> 5)) * 512 + (row & 15) * 32 + (col0 & 31);
                float a[8], b[8], o[8];
#pragma unroll
                for (int i = 0; i < 4; ++i) { a[i] = acc[ai][0][m][0][i]; a[4 + i] = acc[ai][0][m][1][i]; b[i] = acc[ai][1][m][0][i]; b[4 + i] = acc[ai][1][m][1][i]; }
                if (type == 0) {
#pragma unroll
                    for (int i = 0; i < 8; ++i) o[i] = a[i] * rcp((1.0f + ex2(gelu_arg(a[i]))) * (1.0f + ex2(-L2E * b[i])));
                    *(u32x4*)(GAU + off) = pack8(o);
                } else if (type == 1) {
#pragma unroll
                    for (int i = 0; i < 8; ++i) o[i] = a[i] * rcp((1.0f + ex2(-L2E * a[i])) * (1.0f + ex2(-L2E * b[i])));
                    __builtin_nontemporal_store(pack8(o), (u32x4*)(GBOG + off));
                } else if (type == 2) {
                    float s = 0.f, ss = 0.f;
#pragma unroll
                    for (int i = 0; i < 8; ++i) { o[i] = a[i] * rcp(1.0f + ex2(gelu_arg(a[i]))); s += o[i]; ss += o[i] * o[i]; }
                    *(u32x4*)(GV + off) = pack8(o);
#pragma unroll
                    for (int i = 0; i < 8; ++i) o[i] = b[i] * rcp(1.0f + ex2(-L2E * b[i]));
                    __builtin_nontemporal_store(pack8(o), (u32x4*)(QS + off));
                    s += __shfl_xor(s, 16); ss += __shfl_xor(ss, 16); s += __shfl_xor(s, 32); ss += __shfl_xor(ss, 32);
                    if (fq == 0) *(f32x2*)(VSTAT + ((size_t)row * 32 + 4 * j + wc) * 2) = (f32x2){s, ss};
                } else {
#pragma unroll
                    for (int i = 0; i < 8; ++i) { const float sg = rcp(1.0f + ex2(-L2E * a[i])); o[i] = 0.6931471805599453f * __builtin_amdgcn_logf(lb[i] + (1.0f - lb[i]) * sg); }
                    __builtin_nontemporal_store(pack8(o), (u32x4*)(G + off));
                    __builtin_nontemporal_store(pack8(b), (u32x4*)(IV + off));
                }
            }
    }
};
struct EpiF32 {
    static constexpr bool PERM = false, AFTER_DRAIN = false;
    float* C; int ldc;
    __device__ __forceinline__ void operator()(const f32x4 (&acc)[2][2][4][2], const Unit& u, int wr, int wc, int fr, int fq) const {
        const int row0 = u.pm * BM + wr * 64 + fr, col0 = u.pn * BM + wc * 32 + 4 * fq;
#pragma unroll
        for (int ai = 0; ai < 2; ++ai)
#pragma unroll
            for (int m = 0; m < 4; ++m) { float* rowp = C + (size_t)(row0 + ai * HALF + m * 16) * ldc + col0;
#pragma unroll
                for (int bj = 0; bj < 2; ++bj)
#pragma unroll
                    for (int n = 0; n < 2; ++n) *(f32x4*)(rowp + bj * HALF + n * 16) = acc[ai][bj][m][n]; }
    }
};
struct EpiMoe1 {
    static constexpr bool PERM = true, AFTER_DRAIN = false;
    bf16_t* ACT; int act_bytes;
    __device__ __forceinline__ void operator()(const f32x4 (&acc)[2][2][4][2], const Unit& u, int wr, int wc, int fr, int fq) const {
        const int row0 = u.pm * BM + wr * 64 + fr, col0 = 128 * u.pn + wc * 32 + 8 * fq;
        const __amdgpu_buffer_rsrc_t rs = __builtin_amdgcn_make_buffer_rsrc(ACT, 0, act_bytes, 0x00020000);
#pragma unroll
        for (int ai = 0; ai < 2; ++ai)
#pragma unroll
            for (int m = 0; m < 4; ++m) { float o[8];
#pragma unroll
                for (int i = 0; i < 4; ++i) { const float a0 = acc[ai][0][m][0][i], a1 = acc[ai][0][m][1][i];
                    o[i] = a0 * acc[ai][1][m][0][i] * rcp(1.0f + ex2(-L2E * a0)); o[4 + i] = a1 * acc[ai][1][m][1][i] * rcp(1.0f + ex2(-L2E * a1)); }
                __builtin_amdgcn_raw_buffer_store_b128(pack8(o), rs, (unsigned)(((row0 + ai * HALF + m * 16) * 512 + col0) * 2), 0,   16); }
    }
};
struct EpiBf16 {
    static constexpr bool PERM = true, AFTER_DRAIN = false;
    bf16_t* O; int ldc;
    __device__ __forceinline__ void operator()(const f32x4 (&acc)[2][2][4][2], const Unit& u, int wr, int wc, int fr, int fq) const {
        const int row0 = u.pm * BM + wr * 64 + fr, col0 = u.pn * BM + wc * 32 + 8 * fq;
#pragma unroll
        for (int ai = 0; ai < 2; ++ai)
#pragma unroll
            for (int m = 0; m < 4; ++m) { bf16_t* rowp = O + (size_t)(row0 + ai * HALF + m * 16) * ldc + col0;
#pragma unroll
                for (int bj = 0; bj < 2; ++bj) { const f32x4 v0 = acc[ai][bj][m][0], v1 = acc[ai][bj][m][1]; u32x4 w;
                    w.x = cvt_pk_bf16(v0[0], v0[1]); w.y = cvt_pk_bf16(v0[2], v0[3]); w.z = cvt_pk_bf16(v1[0], v1[1]); w.w = cvt_pk_bf16(v1[2], v1[3]);
                    *(u32x4*)(rowp + bj * HALF) = w; } }
    }
};
struct GroupedOrder {
    const PG8_LAS int* offs; int nN, nwg, G, c;
    __device__ void init(const PG8_LAS int* offs_, int N, int G_, int c_) { offs = offs_; nN = N / BM; nwg = (offs_[16] / BM) * nN; G = G_; c = c_; }
    __device__ bool next(int i, Unit& u) const { return unit_of((long)i * G + c, u); }
    __device__ bool unit_of(const long L, Unit& u) const {
        if (L >= nwg) return false;
        int wgid = (int)L; { const int q = nwg / NXCD, r = nwg % NXCD, xcd = wgid % NXCD, off = wgid / NXCD; wgid = (xcd < r ? xcd * (q + 1) : r * (q + 1) + (xcd - r) * q) + off; }
        u.pm = wgid / nN; u.pn = wgid % nN; const int row = u.pm * BM; int e = 0;
#pragma unroll
        for (int k = 1; k < 16; ++k) e += (row >= offs[k]) ? 1 : 0;
        u.pnb = e * nN + u.pn; return true;
    }
    __device__ __forceinline__ void a_ready(const Unit&) const {}
    __device__ __forceinline__ void done(const Unit&) const {}
    __device__ __forceinline__ void done_deferred(const Unit&) const {}
};
struct GroupedSignal : GroupedOrder {
    unsigned* cnt;
    __device__ __forceinline__ void done_deferred(const Unit& u) const { if ((threadIdx.x & 63) == 0) (void)__hip_atomic_fetch_add(cnt + 64 * u.pm, 1u, __ATOMIC_RELAXED, __HIP_MEMORY_SCOPE_AGENT); }
};
struct GroupedWait : GroupedOrder {
    const unsigned* cnt; unsigned need;
    unsigned* qcnt; int xcd; PG8_LAS int* slot;
    __device__ bool next(int i, Unit& u) const {
        PG8_LAS int* sl = slot + (i & 1);
        if (threadIdx.x == 0) { int L = -1;
            for (int k = 0; k < NXCD; ++k) { const int q = (xcd + k) & (NXCD - 1); const int t = (int)__hip_atomic_fetch_add(qcnt + 64 * q, 1u, __ATOMIC_RELAXED, __HIP_MEMORY_SCOPE_AGENT); const int l = q + NXCD * t; if (l < nwg) { L = l; break; } }
            *(volatile PG8_LAS int*)sl = L; }
        asm volatile("s_waitcnt lgkmcnt(0)" ::: "memory"); __builtin_amdgcn_s_barrier(); asm volatile("" ::: "memory");
        const int L = *(volatile PG8_LAS int*)sl;
        if (L < 0) return false; return unit_of(L, u);
    }
    __device__ __forceinline__ void a_ready(const Unit& u) const {
        if (threadIdx.x < 64) { unsigned sp = 0;
            while ((unsigned)__builtin_amdgcn_readfirstlane((int)__hip_atomic_load(cnt + 64 * u.pm, __ATOMIC_RELAXED, __HIP_MEMORY_SCOPE_AGENT)) < need) { __builtin_amdgcn_s_sleep(2); if (++sp > (1u << 22)) break; }
            __builtin_amdgcn_fence(__ATOMIC_ACQUIRE, "agent");
            asm volatile("s_waitcnt vmcnt(0)" ::: "memory"); }
        asm volatile("" ::: "memory"); __builtin_amdgcn_s_barrier(); asm volatile("" ::: "memory");
    }
};
template <class Epi, class Sched, bool ALIGN_EPI = false, bool SP2 = false, bool GATHER = false>
__device__ __forceinline__ void gemm_phase(PG8_LAS unsigned char* lds, const Gemm g, const Sched& S, const Epi& E) {
    const int tid = threadIdx.x, wid = __builtin_amdgcn_readfirstlane(tid >> 6), lane = tid & 63, wr = wid >> 2, wc = wid & 3, fr = lane & 15, fq = lane >> 4;
    const int K = g.K, nt = K / BK;
    unsigned voffA[2], voffB[2];
#pragma unroll
    for (int i = 0; i < 2; ++i) { int R, C; stage_rc(tid * 16 + i * 8192, R, C); const int Rb = Epi::PERM ? ((R & ~31) + perm32(R & 31)) : R;
        voffA[i] = (unsigned)(R * K + C) * 2u; voffB[i] = (unsigned)(Rb * K + C) * 2u; }
    const size_t kstep = (size_t)(BK * 2);
    const size_t hstep = (size_t)HALF * K * 2;
    const size_t tstep = 2 * hstep;
    const unsigned ldsw = (unsigned)wid * 1024u;
    const int aoff = lds_byte(wr * 64 + fr, fq * 8), boff = lds_byte(wc * 32 + fr, fq * 8);
#define PG8_SA(b, h) (((b) * 2 + (h)) * HTB)
#define PG8_SB(b, h) ((4 + (b) * 2 + (h)) * HTB)
#define PG8_STAGE(bufoff, gbase, voff) do { _Pragma("unroll") for (int _i = 0; _i < 2; ++_i) \
        __builtin_amdgcn_global_load_lds((const unsigned*)((const char*)(gbase) + (voff)[_i]), (PG8_LAS unsigned*)(lds + (bufoff) + ldsw + _i * 8192), 16, 0, 0); } while (0)
#define PG8_STAGE_A(bufoff, gbase, half, selnext) do { if constexpr (GATHER) { unsigned vo_[2]; vo_[0] = (selnext) ? nv[half][0] : cv[half][0]; vo_[1] = (selnext) ? nv[half][1] : cv[half][1]; PG8_STAGE(bufoff, gbase, vo_); } \
        else { PG8_STAGE(bufoff, (gbase) + (half) * hstep, voffA); } } while (0)
#define PG8_LDA(dst, b, h) do { _Pragma("unroll") for (int m = 0; m < 4; ++m) _Pragma("unroll") for (int k = 0; k < 2; ++k) dst[m][k] = *(const PG8_LAS bf16x8*)(lds + PG8_SA(b, h) + aoff + m * 2048 + k * 1024); } while (0)
#define PG8_LDB(dst, b, h) do { _Pragma("unroll") for (int n = 0; n < 2; ++n) _Pragma("unroll") for (int k = 0; k < 2; ++k) dst[n][k] = *(const PG8_LAS bf16x8*)(lds + PG8_SB(b, h) + boff + n * 2048 + k * 1024); } while (0)
#define PG8_MMA(ai, bj, At, Bt) do { __builtin_amdgcn_s_setprio(1); _Pragma("unroll") for (int m = 0; m < 4; ++m) _Pragma("unroll") for (int n = 0; n < 2; ++n) _Pragma("unroll") for (int k = 0; k < 2; ++k) \
        acc[ai][bj][m][n] = __builtin_amdgcn_mfma_f32_16x16x32_bf16(Bt[n][k], At[m][k], acc[ai][bj][m][n], 0, 0, 0); __builtin_amdgcn_s_setprio(0); } while (0)
#define PG8_WAIT_V(n) asm volatile("s_waitcnt vmcnt(" #n ")" ::: "memory")
#define PG8_WAIT_L(n) asm volatile("s_waitcnt lgkmcnt(" #n ")" ::: "memory")
#define PG8_BAR __builtin_amdgcn_s_barrier()
#define PG8_SCHED __builtin_amdgcn_sched_barrier(0)
    Unit cur, nxt, prv; int ui = 0;
    if (!S.next(0, cur)) return;
    prv = cur;
    f32x4 acc[2][2][4][2];
#pragma unroll
    for (int a = 0; a < 2; ++a)
#pragma unroll
        for (int b = 0; b < 2; ++b)
#pragma unroll
            for (int m = 0; m < 4; ++m)
#pragma unroll
                for (int n = 0; n < 2; ++n) acc[a][b][m][n] = (f32x4){0.f, 0.f, 0.f, 0.f};
    bf16x8 At[4][2], B0[2][2], B1[2][2];
    unsigned cv[2][2], nv[2][2], aR[2], aC2[2];
    if constexpr (GATHER) {
#pragma unroll
        for (int i = 0; i < 2; ++i) { int R, C; stage_rc(tid * 16 + i * 8192, R, C); aR[i] = (unsigned)R; aC2[i] = (unsigned)C * 2u; }
#pragma unroll
        for (int h = 0; h < 2; ++h)
#pragma unroll
            for (int i = 0; i < 2; ++i) { cv[h][i] = (unsigned)g.sidx[h * HALF + aR[i]] * (unsigned)(K * 2) + aC2[i]; nv[h][i] = cv[h][i]; } }
    const char* cA = (const char*)g.A + (GATHER ? (size_t)0 : (size_t)cur.pm * tstep); const char* cB = (const char*)g.Bt + (size_t)cur.pnb * tstep;
    S.a_ready(cur);
    if constexpr (SP2) {
        PG8_STAGE(PG8_SB(0, 0), cB, voffB); PG8_STAGE(PG8_SB(0, 1), cB + hstep, voffB); PG8_STAGE_A(PG8_SA(0, 0), cA, 0, false); PG8_STAGE_A(PG8_SA(0, 1), cA, 1, false);
        if (wr == 1) PG8_BAR;
        PG8_WAIT_V(2); PG8_BAR;
        PG8_STAGE(PG8_SB(1, 0), cB + kstep, voffB); PG8_STAGE_A(PG8_SA(1, 0), cA + kstep, 0, false); PG8_STAGE(PG8_SB(1, 1), cB + hstep + kstep, voffB);
        PG8_WAIT_V(6); PG8_BAR;
    } else {
        PG8_STAGE(PG8_SB(0, 0), cB, voffB); PG8_STAGE_A(PG8_SA(0, 0), cA, 0, false); PG8_STAGE(PG8_SB(0, 1), cB + hstep, voffB); PG8_STAGE_A(PG8_SA(0, 1), cA, 1, false);
        if (wr == 1) PG8_BAR;
        PG8_WAIT_V(4); PG8_BAR;
        PG8_STAGE(PG8_SB(1, 0), cB + kstep, voffB); PG8_STAGE_A(PG8_SA(1, 0), cA + kstep, 0, false); PG8_STAGE(PG8_SB(1, 1), cB + hstep + kstep, voffB);
        PG8_WAIT_V(6); PG8_BAR;
    }
    for (;;) {
        const bool has_next = S.next(ui + 1, nxt);
        if constexpr (GATHER) { if (has_next) {
#pragma unroll
            for (int h = 0; h < 2; ++h)
#pragma unroll
                for (int i = 0; i < 2; ++i) nv[h][i] = (unsigned)g.sidx[(ui + 1) * BM + h * HALF + aR[i]] * (unsigned)(K * 2) + aC2[i]; } }
        const bool lastnext_ok = has_next;
        const char* nA = (has_next && !GATHER) ? (const char*)g.A + (size_t)nxt.pm * tstep : cA; const char* nB = has_next ? (const char*)g.Bt + (size_t)nxt.pnb * tstep : cB;
        for (int t = 0; t < nt; t += 2) {
            const bool last = (t == nt - 2); const bool lastnext = last && lastnext_ok;
            const char* a1 = cA + (size_t)(t + 1) * kstep;
            const char* a2 = last ? nA : cA + (size_t)(t + 2) * kstep; const char* b2 = last ? nB : cB + (size_t)(t + 2) * kstep;
            const char* a3 = a2 + kstep; const char* b3 = b2 + kstep;
            if (last && ui > 0) S.done_deferred(prv);
            if (last && has_next) S.a_ready(nxt);
            if constexpr (SP2) {
            PG8_LDB(B0, 0, 0); PG8_LDB(B1, 0, 1); PG8_SCHED; PG8_LDA(At, 0, 0); PG8_STAGE_A(PG8_SA(1, 1), a1, 1, false);
            PG8_WAIT_V(8); PG8_WAIT_L(0); PG8_BAR; PG8_MMA(0, 0, At, B0); PG8_MMA(0, 1, At, B1); PG8_BAR; PG8_SCHED;
            PG8_LDA(At, 0, 1); PG8_STAGE(PG8_SB(0, 0), b2, voffB); PG8_STAGE(PG8_SB(0, 1), b2 + hstep, voffB); PG8_STAGE_A(PG8_SA(0, 0), a2, 0, lastnext);
            PG8_WAIT_V(8); PG8_WAIT_L(0); PG8_BAR; PG8_MMA(1, 0, At, B0); PG8_MMA(1, 1, At, B1); PG8_BAR; PG8_SCHED;
            PG8_LDB(B0, 1, 0); PG8_LDB(B1, 1, 1); PG8_SCHED; PG8_LDA(At, 1, 0); PG8_STAGE_A(PG8_SA(0, 1), a2, 1, lastnext);
            PG8_WAIT_V(8); PG8_WAIT_L(0); PG8_BAR; PG8_MMA(0, 0, At, B0); PG8_MMA(0, 1, At, B1); PG8_BAR; PG8_SCHED;
            PG8_LDA(At, 1, 1); PG8_STAGE(PG8_SB(1, 0), b3, voffB); PG8_STAGE(PG8_SB(1, 1), b3 + hstep, voffB); PG8_STAGE_A(PG8_SA(1, 0), a3, 0, lastnext);
            PG8_WAIT_V(8); PG8_WAIT_L(0); PG8_BAR; PG8_MMA(1, 0, At, B0); PG8_MMA(1, 1, At, B1); PG8_BAR; PG8_SCHED;
            } else {
            PG8_LDB(B0, 0, 0); PG8_SCHED; PG8_LDA(At, 0, 0); PG8_STAGE_A(PG8_SA(1, 1), a1, 1, false);
            PG8_WAIT_L(8); PG8_BAR; PG8_WAIT_L(0); PG8_MMA(0, 0, At, B0); PG8_BAR; PG8_SCHED;
            PG8_LDB(B1, 0, 1); PG8_STAGE(PG8_SB(0, 0), b2, voffB);
            PG8_BAR; PG8_WAIT_L(0); PG8_MMA(0, 1, At, B1); PG8_BAR;
            PG8_LDA(At, 0, 1); PG8_STAGE_A(PG8_SA(0, 0), a2, 0, lastnext);
            PG8_BAR; PG8_WAIT_L(0); PG8_MMA(1, 0, At, B0); PG8_BAR; PG8_SCHED;
            PG8_STAGE(PG8_SB(0, 1), b2 + hstep, voffB);
            PG8_WAIT_V(6); PG8_BAR; PG8_MMA(1, 1, At, B1); PG8_BAR;
            PG8_LDB(B0, 1, 0); PG8_SCHED; PG8_LDA(At, 1, 0); PG8_STAGE_A(PG8_SA(0, 1), a2, 1, lastnext);
            PG8_WAIT_L(8); PG8_BAR; PG8_WAIT_L(0); PG8_MMA(0, 0, At, B0); PG8_BAR; PG8_SCHED;
            PG8_LDB(B1, 1, 1); PG8_STAGE(PG8_SB(1, 0), b3, voffB);
            PG8_BAR; PG8_WAIT_L(0); PG8_MMA(0, 1, At, B1); PG8_BAR;
            PG8_LDA(At, 1, 1); PG8_STAGE_A(PG8_SA(1, 0), a3, 0, lastnext);
            PG8_BAR; PG8_WAIT_L(0); PG8_MMA(1, 0, At, B0); PG8_BAR; PG8_SCHED;
            PG8_STAGE(PG8_SB(1, 1), b3 + hstep, voffB);
            PG8_WAIT_V(6); PG8_BAR; PG8_MMA(1, 1, At, B1); PG8_BAR;
            }
        }
        if constexpr (ALIGN_EPI) { if (wr == 0) PG8_BAR; }
        if constexpr (!Epi::AFTER_DRAIN) { E(acc, cur, wr, wc, fr, fq); S.done(cur); }
        if (!has_next) break;
#pragma unroll
        for (int a = 0; a < 2; ++a)
#pragma unroll
            for (int b = 0; b < 2; ++b)
#pragma unroll
                for (int m = 0; m < 4; ++m)
#pragma unroll
                    for (int n = 0; n < 2; ++n) acc[a][b][m][n] = (f32x4){0.f, 0.f, 0.f, 0.f};
        prv = cur; cur = nxt; cA = nA; cB = nB; ++ui;
        if constexpr (GATHER) {
#pragma unroll
            for (int h = 0; h < 2; ++h)
#pragma unroll
                for (int i = 0; i < 2; ++i) cv[h][i] = nv[h][i]; }
        if constexpr (ALIGN_EPI) { if (wr == 1) PG8_BAR; }
    }
    PG8_WAIT_V(0);
    if constexpr (!Epi::AFTER_DRAIN) S.done_deferred(cur);
    if constexpr (!ALIGN_EPI) { if (wr == 0) PG8_BAR; }
    PG8_BAR;
    if constexpr (Epi::AFTER_DRAIN) { E.fused(acc, cur, wr, wc, fr, fq, lds, wid, lane); S.done(cur); }
#undef PG8_SA
#undef PG8_SB
#undef PG8_STAGE
#undef PG8_STAGE_A
#undef PG8_LDA
#undef PG8_LDB
#undef PG8_MMA
#undef PG8_WAIT_V
#undef PG8_WAIT_L
#undef PG8_BAR
#undef PG8_SCHED
}
}

#define XB_TMO      128
#define XB_XCNT(j)  (256  + 64 * (j))
#define XB_XSUB(j)  (1280 + 64 * (j))
#define XB_XGEN(j)  (2304 + 64 * (j))
#define XB_TOP      3328
#define XB_TOPGEN   3392
#define XCD_BAR_WORDS 3456
#define XB_SPIN_CAP (1u << 18)
__device__ __forceinline__ unsigned xb_ld(unsigned* p)              { return __hip_atomic_load(p, __ATOMIC_RELAXED, __HIP_MEMORY_SCOPE_AGENT); }
__device__ __forceinline__ unsigned xb_add(unsigned* p, unsigned v) { return __hip_atomic_fetch_add(p, v, __ATOMIC_RELAXED, __HIP_MEMORY_SCOPE_AGENT); }
__device__ __forceinline__ unsigned xb_xcc_id() { return (unsigned)__builtin_amdgcn_s_getreg((3 << 11) | 20) & 0xFu; }
#define XB_SPIN(cond, bar) do { unsigned _sp = 0; while (cond) { __builtin_amdgcn_s_sleep(1); \
    if ((++_sp & 255u) == 0u) { if (xb_ld(&(bar)[XB_TMO])) break; if (_sp > XB_SPIN_CAP) { atomicAdd(&(bar)[XB_TMO], 1u); break; } } } } while (0)
struct XcdBarrier { unsigned* bar; unsigned x; volatile LAS unsigned* st; };
__device__ __forceinline__ XcdBarrier xcd_barrier_post(unsigned* bar, volatile LAS unsigned* st) {
    XcdBarrier b; b.bar = bar; b.x = xb_xcc_id(); b.st = st;
    if (threadIdx.x == 0) (void)xb_add(&bar[XB_XCNT(b.x)], 1u);
    return b;
}
__device__ __forceinline__ void xcd_barrier_complete(unsigned* bar, unsigned x, unsigned& nloc, unsigned& nx) {
    const unsigned G = gridDim.x * gridDim.y * gridDim.z;
    unsigned sum, cnt, mine, sp = 0u;
    for (;;) {
        sum = 0u; cnt = 0u; mine = 0u;
#pragma unroll
        for (unsigned j = 0; j < 16; ++j) { const unsigned c = xb_ld(&bar[XB_XCNT(j)]); sum += c; cnt += (c > 0u) ? 1u : 0u; mine = (j == x) ? c : mine; }
        if (sum == G) break;
        __builtin_amdgcn_s_sleep(1);
        if ((++sp & 255u) == 0u) { if (xb_ld(&bar[XB_TMO])) break; if (sp > XB_SPIN_CAP) { atomicAdd(&bar[XB_TMO], 1u); break; } }
    }
    nloc = mine > 0u ? mine : 1u; nx = cnt > 0u ? cnt : 1u;
}
__device__ __forceinline__ void xcd_barrier(const XcdBarrier& b) {
    asm volatile("s_waitcnt vmcnt(0)" ::: "memory");
    __syncthreads();
    if (threadIdx.x == 0) {
        unsigned* bar = b.bar;
        __builtin_amdgcn_s_waitcnt(0);
        unsigned nloc = b.st[0], nx = b.st[1];
        if (nloc == 0u) { xcd_barrier_complete(bar, b.x, nloc, nx); b.st[0] = nloc; b.st[1] = nx; }
        const unsigned old = xb_add(&bar[XB_XSUB(b.x)], 1u);
        const unsigned gen = old / nloc;
        if (old + 1u == (gen + 1u) * nloc) {
            __builtin_amdgcn_fence(__ATOMIC_RELEASE, "agent");
            asm volatile("s_waitcnt vmcnt(0)" ::: "memory");
            const unsigned og = xb_add(&bar[XB_TOP], 1u);
            const unsigned tg = og / nx;
            __builtin_amdgcn_fence(__ATOMIC_ACQUIRE, "agent");
            if (og + 1u == (tg + 1u) * nx) xb_add(&bar[XB_TOPGEN], 1u);
            else XB_SPIN(xb_ld(&bar[XB_TOPGEN]) == tg, bar);
            xb_add(&bar[XB_XGEN(b.x)], 1u);
            asm volatile("s_waitcnt vmcnt(0)" ::: "memory");
        } else {
            __builtin_amdgcn_fence(__ATOMIC_ACQUIRE, "agent");
            XB_SPIN(xb_ld(&bar[XB_XGEN(b.x)]) == gen, bar);
            asm volatile("s_waitcnt vmcnt(0)" ::: "memory");
        }
    }
    __syncthreads();
}
constexpr int CW_YA = 8192;
constexpr int CW_BAR = 4096;

struct Args { const float* in[23]; float* out; unsigned char* ws; int ph_lo, ph_hi, li, pad; };
enum { I_X = 0, I_C, I_WADA, I_BADA, I_GPREMIX, I_GPOSTMIX, I_WIN, I_LNVG, I_LNVB, I_WSP, I_BSP, I_LBL, I_GHGRN, I_WOUT, I_GPREFFN, I_GPOSTFFN, I_WRG, I_BRG, I_WRE, I_BRE, I_W1, I_W3, I_W2 };
enum { PH_PREP = 0, PH_HNORM, PH_INPROJ, PH_MIXA, PH_MIXB, PH_OUTPROJ, PH_ROW1, PH_GATHER, PH_MOE1, PH_MOE2, PH_FINAL, PH_N };

struct Frame {
    LAS unsigned char* lds;
    int tid, lane, wave, vcu, G;
};
typedef const __attribute__((address_space(4))) Args KArgs;
__device__ __forceinline__ KArgs* kargs() { KArgs* p = (KArgs*)__builtin_amdgcn_kernarg_segment_ptr(); asm volatile("" : "+s"(p)); return p; }

__host__ __device__ __forceinline__ size_t blk(size_t row, int col) { return ((row >> 4) * 32 + (size_t)(col >> 5)) * 512 + (row & 15) * 32 + (col & 31); }
__host__ __device__ __forceinline__ int inproj_row(int n) {
    const int s = n >> 10, ch = n & 1023, j = ch >> 7, cc = ch & 127;
    const int type = (s == 0 || s == 6) ? 0 : (s == 5 || s == 7) ? 1 : (s == 1 || s == 2) ? 2 : 3;
    const int bj = (s == 0 || s == 5 || s == 1 || s == 3) ? 0 : 1;
    return 256 * (4 * j + type) + 128 * bj + cc;
}

__device__ __forceinline__ void transpose_item(const float* W, int N, int k0, int n0, bf16* WT, int Kd, int r0, LAS float* scr, int lane) {
    const int kr = lane >> 3, nq = lane & 7;
    f32x4 v[8];
#pragma unroll
    for (int i = 0; i < 8; ++i) v[i] = *(const f32x4*)(W + (size_t)(k0 + 8 * i + kr) * N + n0 + 4 * nq);
#pragma unroll
    for (int i = 0; i < 8; ++i) { LAS float* d = scr + (8 * i + kr) * 33 + 4 * nq; d[0] = v[i][0]; d[1] = v[i][1]; d[2] = v[i][2]; d[3] = v[i][3]; }
    LDS_WAIT(); asm volatile("" ::: "memory");
    const int c = lane & 7;
#pragma unroll
    for (int j = 0; j < 4; ++j) { const int n = (lane >> 3) + 8 * j; const LAS float* s = scr + (8 * c) * 33 + n;
        v4u o; o.x = pk2(s[0 * 33], s[1 * 33]); o.y = pk2(s[2 * 33], s[3 * 33]); o.z = pk2(s[4 * 33], s[5 * 33]); o.w = pk2(s[6 * 33], s[7 * 33]);
        *(GAS v4u*)(WT + (size_t)(r0 + n) * Kd + k0 + 8 * c) = o; }
    LDS_WAIT(); asm volatile("" ::: "memory");
}

struct TrDesc { const float* W; bf16* WT; int N, k0, n0, Kd, r0; };
template <bool NT> __device__ __forceinline__ f32x4 tr_ld(const f32x4* p) { return NT ? __builtin_nontemporal_load(p) : *p; }
template <bool NT = false> __device__ __forceinline__ void tr_load(f32x4 (&v)[8], const TrDesc& d, int lane) {
    const int kr = lane >> 3, nq = lane & 7;
#pragma unroll
    for (int i = 0; i < 8; ++i) v[i] = tr_ld<NT>((const f32x4*)(d.W + (size_t)(d.k0 + 8 * i + kr) * d.N + d.n0 + 4 * nq));
    asm volatile("" ::: "memory");
}
__device__ __forceinline__ void tr_to_lds(const f32x4 (&v)[8], LAS float* scr, int lane) {
    const int kr = lane >> 3, nq = lane & 7;
#pragma unroll
    for (int i = 0; i < 8; ++i) { LAS float* d = scr + (8 * i + kr) * 33 + 4 * nq; d[0] = v[i][0]; d[1] = v[i][1]; d[2] = v[i][2]; d[3] = v[i][3]; }
    LDS_WAIT(); asm volatile("" ::: "memory");
}
template <bool NT = false> __device__ __forceinline__ void tr_store(const TrDesc& d, LAS float* scr, int lane) {
    const int c = lane & 7;
#pragma unroll
    for (int j = 0; j < 4; ++j) { const int n = (lane >> 3) + 8 * j; const LAS float* s = scr + (8 * c) * 33 + n;
        v4u o; o.x = pk2(s[0 * 33], s[1 * 33]); o.y = pk2(s[2 * 33], s[3 * 33]); o.z = pk2(s[4 * 33], s[5 * 33]); o.w = pk2(s[6 * 33], s[7 * 33]);
        if (NT) __builtin_nontemporal_store(o, (v4u*)(d.WT + (size_t)(d.r0 + n) * d.Kd + d.k0 + 8 * c)); else *(GAS v4u*)(d.WT + (size_t)(d.r0 + n) * d.Kd + d.k0 + 8 * c) = o; }
    LDS_WAIT(); asm volatile("" ::: "memory");
}
#define TR_PIPELINE(DEC, it0_, stride_, nit_, tv, scr, lane, PRELOADED, NT) do { int it_ = (it0_); if (it_ < (nit_)) { TrDesc d_ = DEC(it_); if (!(PRELOADED)) tr_load<NT>(tv, d_, lane); \
        for (;;) { tr_to_lds(tv, scr, lane); const int nx_ = it_ + (stride_); const bool more_ = nx_ < (nit_); const TrDesc dn_ = DEC(more_ ? nx_ : it_); \
            tr_load<NT>(tv, dn_, lane);                \
            tr_store<NT>(d_, scr, lane); if (!more_) break; d_ = dn_; it_ = nx_; } } } while (0)

__device__ __forceinline__ void phase_prep(Frame& F) {
    const KArgs* ap_ = kargs(); const KArgs& a = *ap_; unsigned char* ws = a.ws;
    if (F.vcu == F.G - 1) { const float* lbl = a.in[I_LBL]; float* lbv = (float*)(ws + WS_LBV);
        for (int c = F.tid; c < D; c += NTHREADS) lbv[c] = 1.0f / (1.0f + expf(lbl[D + c] - lbl[c])); }
    LAS float* sc = (LAS float*)F.lds;
    LAS float* red = (LAS float*)(F.lds + 65536);
    bool have_sc = false;
    for (int u = F.vcu; u < 6144 / 32; u += F.G) {
        if (!have_sc) { const float* c = a.in[I_C];
            for (int i = F.tid; i < 16 * D; i += NTHREADS) sc[i] = silu_f(c[i]);
            have_sc = true; __syncthreads(); }
        const int col = F.tid & 31, kq = F.tid >> 5, j0 = 32 * u;
        float acc[16];
#pragma unroll
        for (int b = 0; b < 16; ++b) acc[b] = 0.f;
        const float* w = a.in[I_WADA] + (size_t)(64 * kq) * 6144 + j0 + col;
        for (int kk = 0; kk < 64; kk += 8) { float wv[8];
#pragma unroll
            for (int q = 0; q < 8; ++q) wv[q] = w[(size_t)(kk + q) * 6144];
#pragma unroll
            for (int b = 0; b < 16; ++b) { const f32x4 s0 = *(const LAS f32x4*)(sc + b * D + 64 * kq + kk), s1 = *(const LAS f32x4*)(sc + b * D + 64 * kq + kk + 4);
                acc[b] += (s0.x * wv[0] + s0.y * wv[1]) + (s0.z * wv[2] + s0.w * wv[3]) + (s1.x * wv[4] + s1.y * wv[5]) + (s1.z * wv[6] + s1.w * wv[7]); } }
#pragma unroll
        for (int b = 0; b < 16; ++b) red[(kq * 16 + b) * 32 + col] = acc[b];
        __syncthreads();
        { const int b = F.tid >> 5; float s = 0.f;
#pragma unroll
          for (int q = 0; q < 16; ++q) s += red[(q * 16 + b) * 32 + col];
          ((float*)(ws + WS_ADA))[b * 6144 + j0 + col] = s + a.in[I_BADA][j0 + col]; }
        __syncthreads();
    }
}

__device__ __forceinline__ void phase_hnorm(Frame& F) {
    const KArgs* ap_ = kargs(); const KArgs& a = *ap_; unsigned char* ws = a.ws;
    const float* ada = (const float*)(ws + WS_ADA); const float* x = a.in[I_X]; const float* g = a.in[I_GPREMIX]; bf16* H = (bf16*)(ws + WS_H);
    const int rows_per = T / F.G, row0 = (int)blockIdx.x * rows_per;
    f32x4 gs[4], shv[4];
    { const float* ab = ada + (size_t)(row0 / SEQ) * 6144;
#pragma unroll
      for (int j = 0; j < 4; ++j) { const int c = 256 * j + 4 * F.lane; gs[j] = *(const f32x4*)(g + c) * (*(const f32x4*)(ab + D + c) + 1.0f); shv[j] = *(const f32x4*)(ab + c); } }
    constexpr int R = 4; const int step = R * NWAVES, n_it = rows_per / step;
    f32x4 va[R][4], vb[R][4];
#define HN_LOAD(V, i0_) do { _Pragma("unroll") for (int r = 0; r < R; ++r) { const f32x4* xr = (const f32x4*)(x + (size_t)(row0 + (i0_) + r * NWAVES) * D) + F.lane; \
            _Pragma("unroll") for (int j = 0; j < 4; ++j) V[r][j] = xr[64 * j]; } asm volatile("" ::: "memory"); } while (0)
#define HN_COMP(V, i0_) do { float s[R]; \
        _Pragma("unroll") for (int r = 0; r < R; ++r) { float t = 0.f; \
            _Pragma("unroll") for (int j = 0; j < 4; ++j) t += (V[r][j].x * V[r][j].x + V[r][j].y * V[r][j].y) + (V[r][j].z * V[r][j].z + V[r][j].w * V[r][j].w); \
            s[r] = t; } \
        _Pragma("unroll") for (int o = 1; o < 64; o <<= 1) { _Pragma("unroll") for (int r = 0; r < R; ++r) s[r] += __shfl_xor(s[r], o); } \
        _Pragma("unroll") for (int r = 0; r < R; ++r) { const float rstd = __builtin_amdgcn_rsqf(s[r] * (1.f / D) + RMS_EPS); \
            unsigned long long* o8 = (unsigned long long*)(H + (size_t)(row0 + (i0_) + r * NWAVES) * D) + F.lane; \
            _Pragma("unroll") for (int j = 0; j < 4; ++j) { const f32x4 h = V[r][j] * rstd * gs[j] + shv[j]; \
                o8[64 * j] = (unsigned long long)pk2(h.x, h.y) | ((unsigned long long)pk2(h.z, h.w) << 32); } } } while (0)
    LAS float* scr = (LAS float*)(F.lds + F.wave * 16384);
    const int gw = F.vcu * NWAVES + F.wave, NGW = F.G * NWAVES;
    constexpr int I_IN = (D / 64) * (NIN / 32), I_OUT = (D / 64) * (D / 32);
    const float* win = a.in[I_WIN]; const float* wout = a.in[I_WOUT];
    auto dec = [&](int it) -> TrDesc { TrDesc d;
        if (it < I_IN) { const int kb = it / (NIN / 32), nb = it % (NIN / 32); d.W = win; d.N = NIN; d.k0 = 64 * kb; d.n0 = 32 * nb; d.WT = (bf16*)(ws + WS_WIN); d.Kd = D; d.r0 = inproj_row(32 * nb); }
        else { const int r = it - I_IN, kb = r / (D / 32), nb = r % (D / 32); d.W = wout; d.N = D; d.k0 = 64 * kb; d.n0 = 32 * nb; d.WT = (bf16*)(ws + WS_WOUT); d.Kd = D; d.r0 = 32 * nb; }
        return d; };
    f32x4 tv[8];
    HN_LOAD(va, F.wave);
    for (int k = 0; k + 2 < n_it; k += 2) {
        HN_LOAD(vb, F.wave + (k + 1) * step); HN_COMP(va, F.wave + k * step);
        HN_LOAD(va, F.wave + (k + 2) * step); HN_COMP(vb, F.wave + (k + 1) * step); }
    { const int k = n_it - 2;
        HN_LOAD(vb, F.wave + (k + 1) * step); HN_COMP(va, F.wave + k * step);
        { const TrDesc d0 = dec(min(gw, I_IN + I_OUT - 1)); tr_load(tv, d0, F.lane); }
        HN_COMP(vb, F.wave + (k + 1) * step); }
#undef HN_LOAD
#undef HN_COMP
    TR_PIPELINE(dec, gw, NGW, I_IN + I_OUT, tv, scr, F.lane, true, false);
}

__device__ __forceinline__ float reduce8_transpose(const float (&a)[8], unsigned lane) {
    float b[4], c[2], d;
    { const bool up = (lane & 32) != 0;
#pragma unroll
      for (int k = 0; k < 4; ++k) { const float keep = up ? a[k + 4] : a[k], send = up ? a[k] : a[k + 4]; b[k] = keep + __shfl_xor(send, 32); } }
    { const bool up = (lane & 16) != 0;
#pragma unroll
      for (int k = 0; k < 2; ++k) { const float keep = up ? b[k + 2] : b[k], send = up ? b[k] : b[k + 2]; c[k] = keep + __shfl_xor(send, 16); } }
    { const bool up = (lane & 8) != 0; const float keep = up ? c[1] : c[0], send = up ? c[0] : c[1]; d = keep + __shfl_xor(send, 8); }
    d += __shfl_xor(d, 4); d += __shfl_xor(d, 2); d += __shfl_xor(d, 1);
    return d;
}
__device__ __forceinline__ void phase_row1(Frame& F) {
    const KArgs* ap_ = kargs(); const KArgs& a = *ap_; unsigned char* ws = a.ws;
    const float* ada = (const float*)(ws + WS_ADA); const float* x = a.in[I_X]; const bf16* y2 = (const bf16*)(ws + WS_Y2);
    const float* gpost = a.in[I_GPOSTMIX]; const float* gpre = a.in[I_GPREFFN];
    const float* wrg = a.in[I_WRG]; const float* brg = a.in[I_BRG]; const float* wre = a.in[I_WRE]; const float* bre = a.in[I_BRE];
    bf16* X1B = (bf16*)(ws + WS_X1); bf16* H2 = (bf16*)(ws + WS_H2); int* EID = (int*)(ws + WS_EID); float* EW = (float*)(ws + WS_EW); int* RANK = (int*)(ws + WS_RANK); int* CNT = (int*)(ws + WS_CNT);
    LAS f32x4* s_wre = (LAS f32x4*)F.lds;
    LAS f32x4* s_wrg = (LAS f32x4*)(F.lds + 65536);
    LAS int* s_eid = (LAS int*)(F.lds + 81920);
    LAS float* s_rb = (LAS float*)(F.lds + 83968 + 8 * 256 * 4);
    if (F.tid < 4) s_rb[F.tid] = brg[F.tid]; else if (F.tid < 20) s_rb[F.tid] = bre[F.tid - 4];
#pragma unroll
    for (int k = 0; k < 8; ++k) { const int n = F.tid + NTHREADS * k, ln = n & 63, o4 = (n >> 6) & 3, jq = n >> 8, c = 256 * (jq >> 2) + 4 * ln + (jq & 3);
        s_wre[n] = *(const f32x4*)(wre + (size_t)c * 16 + 4 * o4); }
#pragma unroll
    for (int k = 0; k < 2; ++k) { const int n = F.tid + NTHREADS * k, ln = n & 63, jq = n >> 6, c = 256 * (jq >> 2) + 4 * ln + (jq & 3);
        s_wrg[n] = *(const f32x4*)(wrg + (size_t)c * 4); }
    __syncthreads();
    const int rows_per = T / F.G, row0 = (int)blockIdx.x * rows_per;
    constexpr int R = 2;
    const LAS f32x4* wre_l = s_wre + F.lane; const LAS f32x4* wrg_l = s_wrg + F.lane;
    asm volatile("" : "+v"(wre_l), "+v"(wrg_l));
    f32x4 gtg[4], gs[4], shv[4];
    { const float* ab = ada + (size_t)(row0 / SEQ) * 6144;
#pragma unroll
      for (int j = 0; j < 4; ++j) { const int c = 256 * j + 4 * F.lane;
          gtg[j] = *(const f32x4*)(ab + 2 * D + c) * *(const f32x4*)(gpost + c); gs[j] = *(const f32x4*)(gpre + c) * (*(const f32x4*)(ab + 4 * D + c) + 1.0f); shv[j] = *(const f32x4*)(ab + 3 * D + c); } }
    f32x4 xv[R][4]; v2u yu[R][4];
#define R1_LOAD(i0_) do { _Pragma("unroll") for (int r = 0; r < R; ++r) { const int m = row0 + (i0_) + r * NWAVES; \
            const v2u* yr = (const v2u*)(y2 + (size_t)m * D) + F.lane; const f32x4* xr = (const f32x4*)(x + (size_t)m * D) + F.lane; \
            _Pragma("unroll") for (int j = 0; j < 4; ++j) { yu[r][j] = yr[64 * j]; xv[r][j] = xr[64 * j]; } } asm volatile("" ::: "memory"); } while (0)
    R1_LOAD(F.wave);
    for (int i0 = F.wave; i0 < rows_per; i0 += R * NWAVES) {
        f32x4 v[R][4]; float s[R];
#pragma unroll
        for (int r = 0; r < R; ++r) { float t = 0.f;
#pragma unroll
            for (int j = 0; j < 4; ++j) { const v2u yy = yu[r][j]; v[r][j] = (f32x4){bf2f(yy.x & 0xffffu), bf2f(yy.x >> 16), bf2f(yy.y & 0xffffu), bf2f(yy.y >> 16)};
                t += (v[r][j].x * v[r][j].x + v[r][j].y * v[r][j].y) + (v[r][j].z * v[r][j].z + v[r][j].w * v[r][j].w); }
            s[r] = t; }
#pragma unroll
        for (int o = 1; o < 64; o <<= 1) {
#pragma unroll
            for (int r = 0; r < R; ++r) s[r] += __shfl_xor(s[r], o); }
        float s2[R];
#pragma unroll
        for (int r = 0; r < R; ++r) { const int m = row0 + i0 + r * NWAVES;
            const float r1 = __builtin_amdgcn_rsqf(s[r] * (1.f / D) + RMS_EPS); float t = 0.f;
#pragma unroll
            for (int j = 0; j < 4; ++j) {
                v[r][j] = xv[r][j] + gtg[j] * (v[r][j] * r1);
                __builtin_nontemporal_store((unsigned long long)pk2(v[r][j].x, v[r][j].y) | ((unsigned long long)pk2(v[r][j].z, v[r][j].w) << 32), (unsigned long long*)(X1B + (size_t)m * D) + F.lane + 64 * j);
                t += (v[r][j].x * v[r][j].x + v[r][j].y * v[r][j].y) + (v[r][j].z * v[r][j].z + v[r][j].w * v[r][j].w); }
            s2[r] = t; }
        R1_LOAD((i0 + R * NWAVES < rows_per) ? i0 + R * NWAVES : i0);
#pragma unroll
        for (int o = 1; o < 64; o <<= 1) {
#pragma unroll
            for (int r = 0; r < R; ++r) s2[r] += __shfl_xor(s2[r], o); }
#pragma unroll
        for (int r = 0; r < R; ++r) { const int m = row0 + i0 + r * NWAVES;
            const float r2 = __builtin_amdgcn_rsqf(s2[r] * (1.f / D) + RMS_EPS);
            unsigned long long* o8 = (unsigned long long*)(H2 + (size_t)m * D) + F.lane;
#pragma unroll
            for (int j = 0; j < 4; ++j) {
                const f32x4 h = v[r][j] * r2 * gs[j] + shv[j]; v[r][j] = h;
                o8[64 * j] = (unsigned long long)pk2(h.x, h.y) | ((unsigned long long)pk2(h.z, h.w) << 32); } }
        LAS float* s_lg = (LAS float*)(F.lds + 83968 + F.wave * 256);
        float pa[4 * R];
#pragma unroll
        for (int k = 0; k < 4 * R; ++k) pa[k] = 0.f;
#pragma unroll
        for (int j = 0; j < 4; ++j) {
#pragma unroll
            for (int q = 0; q < 4; ++q) { const f32x4 wg = wrg_l[(4 * j + q) * 64];
#pragma unroll
                for (int r = 0; r < R; ++r) { const float hv = v[r][j][q]; pa[4 * r] += hv * wg.x; pa[4 * r + 1] += hv * wg.y; pa[4 * r + 2] += hv * wg.z; pa[4 * r + 3] += hv * wg.w; } }
            asm volatile("" ::: "memory"); }
        s_lg[(F.lane >> 3) & 7] = reduce8_transpose(pa, F.lane);
        int gi_[R]; float ptop_[R];
#pragma unroll
        for (int r = 0; r < R; ++r) { const f32x4 glv = *(const LAS f32x4*)(s_lg + 4 * r);
            float gl[4] = {glv.x + s_rb[0], glv.y + s_rb[1], glv.z + s_rb[2], glv.w + s_rb[3]}; int gi = 0;
            float gm = gl[0];
#pragma unroll
            for (int q = 1; q < 4; ++q) if (gl[q] > gm) { gm = gl[q]; gi = q; }
            float gsum = 0.f;
#pragma unroll
            for (int q = 0; q < 4; ++q) gsum += __expf(gl[q] - gm);
            gi_[r] = gi; ptop_[r] = __builtin_amdgcn_rcpf(gsum); }
#pragma unroll
        for (int k = 0; k < 4 * R; ++k) pa[k] = 0.f;
#pragma unroll
        for (int r = 0; r < R; ++r) { const LAS f32x4* wr = wre_l + gi_[r] * 64;
#pragma unroll
            for (int j = 0; j < 4; ++j) {
#pragma unroll
                for (int q = 0; q < 4; ++q) { const f32x4 we = wr[(4 * j + q) * 256]; const float hv = v[r][j][q];
                    pa[4 * r] += hv * we.x; pa[4 * r + 1] += hv * we.y; pa[4 * r + 2] += hv * we.z; pa[4 * r + 3] += hv * we.w; }
                asm volatile("" ::: "memory"); } }
        s_lg[8 + ((F.lane >> 3) & 7)] = reduce8_transpose(pa, F.lane);
#pragma unroll
        for (int r = 0; r < R; ++r) { const int i = i0 + r * NWAVES, m = row0 + i;
            const int gi = gi_[r]; const float ptop = ptop_[r];
            const f32x4 elv = *(const LAS f32x4*)(s_lg + 8 + 4 * r), brv = *(const LAS f32x4*)(s_rb + 4 + 4 * gi);
            float el[4]; el[0] = elv.x + brv.x; el[1] = elv.y + brv.y; el[2] = elv.z + brv.z; el[3] = elv.w + brv.w;
            int i0e = 0; float m0 = el[0];
#pragma unroll
            for (int q = 1; q < 4; ++q) if (el[q] > m0) { m0 = el[q]; i0e = q; }
            int i1 = -1; float m1 = -INFINITY;
#pragma unroll
            for (int q = 0; q < 4; ++q) if (q != i0e && el[q] > m1) { m1 = el[q]; i1 = q; }
            if (i1 < 0) { i1 = (i0e + 1) & 3; m1 = m0; }
            const float e1 = __expf(m1 - m0), w0 = ptop * __builtin_amdgcn_rcpf(1.0f + e1), w1 = w0 * e1;
            if (F.lane == 0) { EID[2 * m] = 4 * gi + i0e; EID[2 * m + 1] = 4 * gi + i1; EW[2 * m] = w0; EW[2 * m + 1] = w1; s_eid[2 * i] = 4 * gi + i0e; s_eid[2 * i + 1] = 4 * gi + i1; }
        }
    }
#undef R1_LOAD
    __syncthreads();
    LAS int* s_wc = (LAS int*)(F.lds + 83968 + 8192 + 128);
    int my_e = -1, my_rank = 0;
    if ((int)F.tid < 2 * rows_per) { my_e = s_eid[F.tid];
#pragma unroll
        for (int ee = 0; ee < NE; ++ee) { const unsigned long long mk = __ballot(my_e == ee);
            if (my_e == ee) my_rank = (int)__builtin_amdgcn_mbcnt_hi((unsigned)(mk >> 32), __builtin_amdgcn_mbcnt_lo((unsigned)mk, 0u));
            if ((int)F.lane == ee) s_wc[F.wave * NE + ee] = __popcll(mk); } }
    else if (F.lane < NE) s_wc[F.wave * NE + F.lane] = 0;
    __syncthreads();
    LAS int* s_gb = s_wc + NWAVES * NE;
    if (F.tid < NE) { int c = 0;
#pragma unroll
        for (int w = 0; w < NWAVES; ++w) c += s_wc[w * NE + F.tid];
        s_gb[F.tid] = (int)__hip_atomic_fetch_add((unsigned*)(ws + WS_CTL) + CW_TOT + 64 * F.tid, (unsigned)c, __ATOMIC_RELAXED, __HIP_MEMORY_SCOPE_AGENT); }
    __syncthreads();
    if ((int)F.tid < 2 * rows_per) { int base = s_gb[my_e];
        for (int w = 0; w < F.wave; ++w) base += s_wc[w * NE + my_e];
        const int lr = base + my_rank;
        RANK[2 * row0 + F.tid] = lr; ((int*)(ws + WS_IDXREL))[my_e * 65536 + lr] = row0 + ((int)F.tid >> 1); }
    __syncthreads();
}

typedef short v4i16 __attribute__((ext_vector_type(4)));
__device__ __forceinline__ unsigned offb(unsigned row, unsigned ch) { return 256u * row + 16u * (ch ^ (((row & 3u) << 2) | ((row >> 2) & 3u))); }
__device__ __forceinline__ unsigned rra16(unsigned lane, unsigned rb, unsigned s) { return offb((lane & 15u) + 16u * rb, 4u * s + (lane >> 4)); }
__device__ __forceinline__ unsigned tra16(unsigned lane, unsigned c, unsigned ks, unsigned t) { const unsigned g = lane >> 4, q = (lane & 15u) >> 2, p = lane & 3u; return offb(32u * ks + 8u * g + 4u * t + q, 2u * c + (p >> 1)) + 8u * (p & 1u); }
__device__ __forceinline__ bf16x8 ldrow(LAS unsigned char* img, unsigned off) { return *(const LAS bf16x8*)(img + off); }
__device__ __forceinline__ bf16x8 ldtr(LAS unsigned char* img, unsigned off0, unsigned off1) {
    const v4i16 x = __builtin_amdgcn_ds_read_tr16_b64_v4i16((LAS v4i16*)(img + off0)), y = __builtin_amdgcn_ds_read_tr16_b64_v4i16((LAS v4i16*)(img + off1));
    return (bf16x8){x[0], x[1], x[2], x[3], y[0], y[1], y[2], y[3]};
}
typedef __bf16 bf16x2_t __attribute__((ext_vector_type(2)));
__device__ __forceinline__ unsigned cvtpk(float lo, float hi) { const f32x2 v = {lo, hi}; const bf16x2_t b = __builtin_convertvector(v, bf16x2_t); return __builtin_bit_cast(unsigned, b); }
__device__ __forceinline__ float bflo(unsigned u) { return __builtin_bit_cast(float, u << 16); }
__device__ __forceinline__ float bfhi(unsigned u) { return __builtin_bit_cast(float, u & 0xffff0000u); }
__device__ __forceinline__ unsigned spoff(unsigned v, unsigned ch) { return 256u * v + 16u * (ch ^ v); }
__device__ __forceinline__ unsigned poff(unsigned t, unsigned ch) { return 128u * t + 16u * (ch ^ (t & 7u)); }
__device__ __forceinline__ unsigned zvoff(unsigned t, unsigned ch) { return 256u * t + 16u * (ch ^ (t & 15u)); }
constexpr int MA_WC = 0, MA_VN = 32768, MA_ZV = 65536, MA_MU = 98304, MA_RS = 98816, MA_CST = 99328;
__device__ __forceinline__ void mixa_units(Frame& F, const int gg, const int u0, const int du, const int nu, unsigned* flag) {
    const KArgs* ap_ = kargs(); const KArgs& a = *ap_; unsigned char* ws = a.ws;
    const bf16 *GAU = (const bf16*)(ws + WS_GAU), *GV = (const bf16*)(ws + WS_GV); const float* VSTAT = (const float*)(ws + WS_VSTAT); bf16* Y = (bf16*)(ws + WS_H);
    const int tid = F.tid, w = F.wave, crow = tid >> 4, cch = tid & 15;
    const __amdgpu_buffer_rsrc_t yrs = __builtin_amdgcn_make_buffer_rsrc(Y, 0, T * D * 2, 0x00020000);
    LAS unsigned char* const WC = F.lds + MA_WC; LAS unsigned char* const VN = F.lds + MA_VN; LAS unsigned char* const ZV = F.lds + MA_ZV;
    LAS float* const s_mu = (LAS float*)(F.lds + MA_MU); LAS float* const s_rs = (LAS float*)(F.lds + MA_RS);
    LAS float* const s_lng = (LAS float*)(F.lds + MA_CST); LAS float* const s_lnb = s_lng + 128; LAS float* const s_bsp = s_lng + 256;
    { const float* W = a.in[I_WSP] + (size_t)gg * 16384;
#pragma unroll
      for (int k = 0; k < 4; ++k) { const int row = crow + 32 * k; const f32x4 w0 = *(const f32x4*)(W + row * 128 + 8 * cch), w1 = *(const f32x4*)(W + row * 128 + 8 * cch + 4);
          float v[8] = {w0[0], w0[1], w0[2], w0[3], w1[0], w1[1], w1[2], w1[3]};
#pragma unroll
          for (int i = 0; i < 8; ++i) v[i] = (8 * cch + i <= row) ? v[i] : 0.f;
          v4u o; o.x = cvtpk(v[0], v[1]); o.y = cvtpk(v[2], v[3]); o.z = cvtpk(v[4], v[5]); o.w = cvtpk(v[6], v[7]);
          *(LAS v4u*)(WC + offb(row, cch)) = o; } }
    if (tid < 128) { s_lng[tid] = a.in[I_LNVG][128 * gg + tid]; s_lnb[tid] = a.in[I_LNVB][128 * gg + tid]; s_bsp[tid] = a.in[I_BSP][128 * gg + tid]; }
    for (int ui = 0; ui < nu; ++ui) { const int u = u0 + ui * du;
        const size_t t0 = (size_t)(u >> 4) * SEQ + 128 * (u & 15);
        unsigned lane = F.lane; asm volatile("" : "+v"(lane));
        const unsigned g = lane >> 4, l15 = lane & 15;
        v4u gvr[4], gar[4];
#pragma unroll
        for (int k = 0; k < 4; ++k) { const size_t off = blk(t0 + crow + 32 * k, 128 * gg + 8 * cch); gvr[k] = *(const v4u*)(GV + off); gar[k] = *(const v4u*)(GAU + off); }
        float mu_ = 0.f, rs_ = 0.f;
        if (tid < 128) { const f32x4* p = (const f32x4*)(VSTAT + (t0 + tid) * 64); float s = 0.f, ss = 0.f;
#pragma unroll
            for (int q = 0; q < 16; ++q) { const f32x4 v = p[q]; s += v[0] + v[2]; ss += v[1] + v[3]; }
            mu_ = s * (1.f / D); rs_ = __builtin_amdgcn_rsqf(ss * (1.f / D) - mu_ * mu_ + LN_EPS); }
        __syncthreads();
        if (tid < 128) { s_mu[tid] = mu_; s_rs[tid] = rs_; }
        __syncthreads();
        { float lng[8], lnb[8];
          { const f32x4 a0 = *(const LAS f32x4*)(s_lng + 8 * cch), a1 = *(const LAS f32x4*)(s_lng + 8 * cch + 4), b0 = *(const LAS f32x4*)(s_lnb + 8 * cch), b1 = *(const LAS f32x4*)(s_lnb + 8 * cch + 4);
#pragma unroll
            for (int i = 0; i < 4; ++i) { lng[i] = a0[i]; lng[4 + i] = a1[i]; lnb[i] = b0[i]; lnb[4 + i] = b1[i]; } }
#pragma unroll
          for (int k = 0; k < 4; ++k) { const int row = crow + 32 * k; const float mu = s_mu[row], rs = s_rs[row]; const v4u x = gvr[k]; v4u o;
              o.x = cvtpk((bflo(x.x) - mu) * rs * lng[0] + lnb[0], (bfhi(x.x) - mu) * rs * lng[1] + lnb[1]); o.y = cvtpk((bflo(x.y) - mu) * rs * lng[2] + lnb[2], (bfhi(x.y) - mu) * rs * lng[3] + lnb[3]);
              o.z = cvtpk((bflo(x.z) - mu) * rs * lng[4] + lnb[4], (bfhi(x.z) - mu) * rs * lng[5] + lnb[5]); o.w = cvtpk((bflo(x.w) - mu) * rs * lng[6] + lnb[6], (bfhi(x.w) - mu) * rs * lng[7] + lnb[7]);
              *(LAS v4u*)(VN + offb(row, cch)) = o; } }
        __syncthreads();
        { bf16x8 va[4];
#pragma unroll
          for (int ks = 0; ks < 4; ++ks) va[ks] = ldtr(VN, tra16(lane, w, ks, 0), tra16(lane, w, ks, 1));
#pragma unroll
          for (int nt = 0; nt < 8; ++nt) { const float bs = s_bsp[16 * nt + l15]; f32x4 acc = (f32x4){bs, bs, bs, bs};
#pragma unroll
              for (int ks = 0; ks < 4; ++ks) if (ks <= nt / 2) acc = __builtin_amdgcn_mfma_f32_16x16x32_bf16(va[ks], ldrow(WC, rra16(lane, nt, ks)), acc, 0, 0, 0);
              *(LAS v2u*)(ZV + zvoff(16 * nt + l15, 2 * w + (g >> 1)) + 8 * (g & 1)) = (v2u){cvtpk(acc[0], acc[1]), cvtpk(acc[2], acc[3])}; } }
        __syncthreads();
#pragma unroll
        for (int k = 0; k < 4; ++k) { const int row = crow + 32 * k; const v4u z = *(const LAS v4u*)(ZV + zvoff(row, cch)), ga = gar[k]; v4u o;
            o.x = cvtpk(bflo(ga.x) * bflo(z.x), bfhi(ga.x) * bfhi(z.x)); o.y = cvtpk(bflo(ga.y) * bflo(z.y), bfhi(ga.y) * bfhi(z.y));
            o.z = cvtpk(bflo(ga.z) * bflo(z.z), bfhi(ga.z) * bfhi(z.z)); o.w = cvtpk(bflo(ga.w) * bflo(z.w), bfhi(ga.w) * bfhi(z.w));
            if (flag) __builtin_amdgcn_raw_buffer_store_b128(o, yrs, (unsigned)(((t0 + row) * D + 128 * gg + 8 * cch) * 2), 0,   16);
            else *(v4u*)(Y + (t0 + row) * D + 128 * gg + 8 * cch) = o; }
        if (flag) { asm volatile("s_waitcnt vmcnt(0)" ::: "memory");
            __syncthreads();
            if (tid == 0) __hip_atomic_store(flag, (unsigned)(ui + 1), RLX_AGENT); }
    }
}
__device__ __forceinline__ void phase_mixa(Frame& F) { mixa_units(F, (int)blockIdx.x & 7, (int)blockIdx.x >> 3, F.G >> 3, (BATCH * (SEQ / 128)) / (F.G >> 3), nullptr); }

constexpr int MC_SP = 0, MC_IV = 32768, MC_QT = 49152, MC_KT = 81920, MC_O = 114688, MC_P = 132096, MC_D = 140288, MC_SQ = 141312, MC_GH = 142336;
__device__ __forceinline__ void moe_weight_copies(Frame& F, int gw, int NGW) {
    const KArgs* ap_ = kargs(); const KArgs& a = *ap_; unsigned char* ws = a.ws;
    LAS float* scr = (LAS float*)(F.lds + F.wave * 16384);
    constexpr int I13 = (D / 64) * (FF / 32), I2 = (FF / 64) * (D / 32);
    const float* w1 = a.in[I_W1]; const float* w3 = a.in[I_W3]; const float* w2 = a.in[I_W2];
    auto dec = [&](int it) -> TrDesc { TrDesc d; const int e = it / (2 * I13 + I2); int r = it % (2 * I13 + I2);
        if (r < 2 * I13) { const int bj = r / I13; r %= I13; const int kb = r / (FF / 32), nb = r % (FF / 32), n0 = 32 * nb;
            d.W = (bj ? w3 : w1) + (size_t)e * D * FF; d.N = FF; d.k0 = 64 * kb; d.n0 = n0; d.WT = (bf16*)(ws + WS_W13) + (size_t)e * D * D; d.Kd = D; d.r0 = 256 * (n0 >> 7) + 128 * bj + (n0 & 127); }
        else { r -= 2 * I13; const int kb = r / (D / 32), nb = r % (D / 32);
            d.W = w2 + (size_t)e * FF * D; d.N = D; d.k0 = 64 * kb; d.n0 = 32 * nb; d.WT = (bf16*)(ws + WS_W2) + (size_t)e * D * FF; d.Kd = FF; d.r0 = 32 * nb; }
        return d; };
    f32x4 tv[8];
    TR_PIPELINE(dec, gw, NGW, NE * (2 * I13 + I2), tv, scr, F.lane, false, true);
}
__device__ __forceinline__ void phase_mixb(Frame& F) {
    if ((int)blockIdx.x >= BATCH * 8) { const int nb = F.G - BATCH * 8, k = (int)blockIdx.x - BATCH * 8;
        const KArgs* ap0_ = kargs(); unsigned* const flag_ = (unsigned*)(ap0_->ws + WS_CTL) + CW_YA + 64 * k;
        if (k < BATCH * 8) mixa_units(F, k & 7, 16 * (k >> 3), 1, SEQ / 128, flag_);
        __syncthreads();
        moe_weight_copies(F, k * NWAVES + F.wave, nb * NWAVES); return; }
    const KArgs* ap_ = kargs(); const KArgs& a = *ap_; unsigned char* ws = a.ws;
    const bf16 *GBOG = (const bf16*)(ws + WS_GBOG), *QS = (const bf16*)(ws + WS_QS), *G = (const bf16*)(ws + WS_G), *IV = (const bf16*)(ws + WS_IV); bf16* Y = (bf16*)(ws + WS_H);
    const int b = (int)blockIdx.x >> 3, h = (int)blockIdx.x & 7, w = F.wave;
    const unsigned lane = F.lane, g = lane >> 4, l15 = lane & 15;
    const bool is_state = w < 4;
    LAS float* const s_d = (LAS float*)(F.lds + MC_D); LAS float* const s_sq = (LAS float*)(F.lds + MC_SQ); LAS float* const s_ghg = (LAS float*)(F.lds + MC_GH);
    LAS unsigned char* const IVI = F.lds + MC_IV; LAS unsigned char* const PB = F.lds + MC_P; LAS unsigned char* const OB = F.lds + MC_O;
    if (F.tid < 128) s_ghg[F.tid] = a.in[I_GHGRN][128 * h + F.tid];
    const size_t tb = (size_t)b * SEQ;
    constexpr int NC = SEQ / 64;
    unsigned* const yaflag = (unsigned*)(ws + WS_CTL) + CW_YA + 64 * (int)blockIdx.x;
    unsigned ya_seen = 0;
#define YA_ENSURE(cs_) do { const unsigned need_ = (unsigned)((cs_) >> 1) + 1u; if (w == 0 && ya_seen < need_) { unsigned v_ = 0; \
        if (lane == 0) { unsigned sp_ = 0; do { v_ = __hip_atomic_load(yaflag, RLX_AGENT); if (v_ >= need_) break; __builtin_amdgcn_s_sleep(8); } while (++sp_ < (1u << 15)); } \
        ya_seen = (unsigned)__builtin_amdgcn_readfirstlane((int)v_); __builtin_amdgcn_fence(__ATOMIC_ACQUIRE, "agent"); asm volatile("s_waitcnt vmcnt(0)" ::: "memory"); } } while (0)
    unsigned ya_v = 0; bool ya_pend = false;
#define YA_ISSUE(cs_) do { const unsigned need_ = (unsigned)((cs_) >> 1) + 1u; ya_pend = (w == 0 && ya_seen < need_); if (ya_pend) ya_v = __hip_atomic_load(yaflag, RLX_AGENT); asm volatile("" ::: "memory"); } while (0)
#define YA_FINISH(cs_) do { if (ya_pend) { const unsigned need_ = (unsigned)((cs_) >> 1) + 1u; unsigned v_ = (unsigned)__builtin_amdgcn_readfirstlane((int)ya_v); \
        if (v_ < need_) { unsigned t_ = v_; if (lane == 0) { unsigned sp_ = 0; do { t_ = __hip_atomic_load(yaflag, RLX_AGENT); if (t_ >= need_) break; __builtin_amdgcn_s_sleep(8); } while (++sp_ < (1u << 15)); } v_ = (unsigned)__builtin_amdgcn_readfirstlane((int)t_); } \
        ya_seen = v_; __builtin_amdgcn_fence(__ATOMIC_ACQUIRE, "agent"); asm volatile("s_waitcnt vmcnt(0)" ::: "memory"); } } while (0)
#define SC_SCORES(pp, q) do { LAS unsigned char* const QT_ = F.lds + MC_QT + (pp) * 16384; LAS unsigned char* const KT_ = F.lds + MC_KT + (pp) * 16384; \
        bf16x8 kf[4]; _Pragma("unroll") for (int ks = 0; ks < 4; ++ks) kf[ks] = ldrow(KT_, rra16(lane, q, ks)); \
        _Pragma("unroll") for (int nt = 0; nt < 4; ++nt) { f32x4 acc = (f32x4){0.f, 0.f, 0.f, 0.f}; \
            if (nt >= q) { bf16x8 qf[4]; _Pragma("unroll") for (int ks = 0; ks < 4; ++ks) qf[ks] = ldrow(QT_, rra16(lane, nt, ks)); \
                _Pragma("unroll") for (int ks = 0; ks < 4; ++ks) acc = __builtin_amdgcn_mfma_f32_16x16x32_bf16(kf[ks], qf[ks], acc, 0, 0, 0); } \
            const int t = 16 * nt + l15, s0 = 16 * q + 4 * g; \
            const float p0 = (s0 + 0 <= t) ? acc[0] : 0.f, p1 = (s0 + 1 <= t) ? acc[1] : 0.f, p2 = (s0 + 2 <= t) ? acc[2] : 0.f, p3 = (s0 + 3 <= t) ? acc[3] : 0.f; \
            *(LAS v2u*)(PB + poff(t, 2 * q + (g >> 1)) + 8 * (g & 1)) = (v2u){cvtpk(p0, p1), cvtpk(p2, p3)}; } } while (0)
    if (!is_state) {
        const int q = w & 3; const unsigned kp = 16 * q + l15, tq = g, st = 64 * q + lane, mrow = st >> 2, mch = 4 * (st & 3);
        const unsigned lGb = 2u * ((((unsigned)tq * 32u + (kp >> 4)) << 9) + 2u * (kp & 15u));
        const unsigned lIb = 2u * (((((unsigned)mrow >> 4) * 32u + (st & 3u)) << 9) + ((unsigned)mrow & 15u) * 32u);
        const unsigned lYb = 2u * ((unsigned)mrow * (unsigned)D + 8u * (unsigned)mch);
#define CH_BLK(p_, cs_) ((const char*)(p_) + 2 * ((((tb >> 4) + 4 * (size_t)(cs_)) * 32 + 4 * (size_t)h) << 9))
#define CH_ROW(p_, cs_) ((const char*)(p_) + 2 * ((tb + 64 * (size_t)(cs_)) * D + 128 * (size_t)h))
        unsigned UA[48], UB[48], V[32];
#define SC_LOAD(U, cs_) do { const char* const gG_ = CH_BLK(G, cs_) + lGb; const char* const gQ_ = CH_BLK(QS, cs_) + lGb; const char* const gI_ = CH_BLK(IV, cs_) + lIb; \
        _Pragma("unroll") for (int i = 0; i < 16; ++i) { U[i] = *(const unsigned*)(gG_ + 64 * i); U[16 + i] = *(const unsigned*)(gQ_ + 64 * i); } \
        _Pragma("unroll") for (int k = 0; k < 4; ++k) { const v4u t_ = *(const v4u*)(gI_ + 16 * k); U[32 + 4 * k] = t_.x; U[33 + 4 * k] = t_.y; U[34 + 4 * k] = t_.z; U[35 + 4 * k] = t_.w; } \
        asm volatile("" ::: "memory"); } while (0)
#define MG_LOAD(cs_) do { const char* const gY_ = CH_ROW(Y, cs_) + lYb; const char* const gB_ = CH_BLK(GBOG, cs_) + lIb; \
        _Pragma("unroll") for (int k = 0; k < 4; ++k) { const v4u ya_ = *(const v4u*)(gY_ + 16 * k), gb_ = *(const v4u*)(gB_ + 16 * k); \
            V[4 * k] = ya_.x; V[4 * k + 1] = ya_.y; V[4 * k + 2] = ya_.z; V[4 * k + 3] = ya_.w; V[16 + 4 * k] = gb_.x; V[17 + 4 * k] = gb_.y; V[18 + 4 * k] = gb_.z; V[19 + 4 * k] = gb_.w; } \
        asm volatile("" ::: "memory"); } while (0)
#define SC_IVIMG(U) do { _Pragma("unroll") for (int k = 0; k < 4; ++k) *(LAS v4u*)(IVI + offb(mrow, mch + k)) = (v4u){U[32 + 4 * k], U[33 + 4 * k], U[34 + 4 * k], U[35 + 4 * k]}; } while (0)
#define SC_SCAN(U, pp) do { float s0_ = 0.f, s1_ = 0.f; _Pragma("unroll") for (int i = 0; i < 16; ++i) { s0_ += bflo(U[i]); s1_ += bfhi(U[i]); } \
        float r0 = 0.f, r1 = 0.f; _Pragma("unroll") for (int j = 1; j < 4; ++j) { const float a0 = __shfl(s0_, (int)(l15 + 16 * j)), a1 = __shfl(s1_, (int)(l15 + 16 * j)); r0 += ((unsigned)j > tq) ? a0 : 0.f; r1 += ((unsigned)j > tq) ? a1 : 0.f; } \
        float E0 = pg8::ex2(r0 * pg8::L2E), E1 = pg8::ex2(r1 * pg8::L2E); unsigned kq_ = kp; asm volatile("" : "+v"(kq_)); const unsigned ab_ = (pp) * 16384 + 4 * (kq_ & 3), kc_ = kq_ >> 2; \
        _Pragma("unroll") for (int i = 15; i >= 0; --i) { const unsigned t = 16 * tq + i; r0 += bflo(U[i]); r1 += bfhi(U[i]); const float n0 = pg8::ex2(r0 * pg8::L2E), n1 = pg8::ex2(r1 * pg8::L2E); \
            const unsigned ad = ab_ + offb(t, kc_); \
            *(LAS unsigned*)(F.lds + MC_QT + ad) = cvtpk(bflo(U[16 + i]) * pg8::rcp(E0), bfhi(U[16 + i]) * pg8::rcp(E1)); *(LAS unsigned*)(F.lds + MC_KT + ad) = cvtpk(E0 - n0, E1 - n1); E0 = n0; E1 = n1; } \
        if (tq == 0) *(LAS f32x2*)(s_d + (pp) * 128 + 2 * kp) = (f32x2){E0, E1}; } while (0)
#define SC_MERGE(c_) do { char* const sY_ = (char*)CH_ROW(Y, c_) + lYb; const f32x4 sq_ = *(const LAS f32x4*)(s_sq + 4 * mrow); \
        const float rstd = __builtin_amdgcn_rsqf(((sq_[0] + sq_[1]) + (sq_[2] + sq_[3])) * (1.f / 128.f) + RMS_EPS); \
        _Pragma("unroll") for (int k = 0; k < 4; ++k) { const v4u o_ = *(const LAS v4u*)(OB + zvoff(mrow, mch + k)); const f32x4 g0 = *(const LAS f32x4*)(s_ghg + 8 * (mch + k)), g1 = *(const LAS f32x4*)(s_ghg + 8 * (mch + k) + 4); v4u y_; \
            y_.x = cvtpk(bflo(V[4 * k]) + bflo(V[16 + 4 * k]) * (bflo(o_.x) * rstd * g0[0]), bfhi(V[4 * k]) + bfhi(V[16 + 4 * k]) * (bfhi(o_.x) * rstd * g0[1])); \
            y_.y = cvtpk(bflo(V[4 * k + 1]) + bflo(V[17 + 4 * k]) * (bflo(o_.y) * rstd * g0[2]), bfhi(V[4 * k + 1]) + bfhi(V[17 + 4 * k]) * (bfhi(o_.y) * rstd * g0[3])); \
            y_.z = cvtpk(bflo(V[4 * k + 2]) + bflo(V[18 + 4 * k]) * (bflo(o_.z) * rstd * g1[0]), bfhi(V[4 * k + 2]) + bfhi(V[18 + 4 * k]) * (bfhi(o_.z) * rstd * g1[1])); \
            y_.w = cvtpk(bflo(V[4 * k + 3]) + bflo(V[19 + 4 * k]) * (bflo(o_.w) * rstd * g1[2]), bfhi(V[4 * k + 3]) + bfhi(V[19 + 4 * k]) * (bfhi(o_.w) * rstd * g1[3])); \
            *(v4u*)(sY_ + 16 * k) = y_; } } while (0)
        SC_LOAD(UA, 0); SC_LOAD(UB, 1); SC_SCAN(UA, 0);
        __syncthreads();
        MG_LOAD(0); SC_IVIMG(UA); SC_LOAD(UA, 2);
        __syncthreads();
        for (int c = 0; c < NC; c += 2) {
            SC_SCAN(UB, 1);
            __syncthreads();
            SC_MERGE(c); MG_LOAD(c + 1); SC_IVIMG(UB); SC_LOAD(UB, min(c + 3, NC - 1));
            __syncthreads();
            SC_SCAN(UA, 0);
            __syncthreads();
            SC_MERGE(c + 1); MG_LOAD(min(c + 2, NC - 1)); SC_IVIMG(UA); SC_LOAD(UA, min(c + 4, NC - 1));
            __syncthreads();
        }
#undef CH_BLK
#undef CH_ROW
#undef SC_LOAD
#undef MG_LOAD
#undef SC_IVIMG
#undef SC_SCAN
#undef SC_MERGE
    } else {
        const int sw = w;
        LAS unsigned char* const SP0 = F.lds + MC_SP + (2 * sw) * 4096;
        f32x4 S[2][8], o[2][4];
#pragma unroll
        for (int j = 0; j < 2; ++j)
#pragma unroll
            for (int c = 0; c < 8; ++c) S[j][c] = (f32x4){0.f, 0.f, 0.f, 0.f};
        unsigned trb[2], trx[2];
#pragma unroll
        for (int t = 0; t < 2; ++t) { const unsigned qq_ = l15 >> 2, p_ = lane & 3, X_ = (qq_ << 2) | ((2 * g + t) & 3); trb[t] = 256u * (8 * g + 4 * t + qq_) + 16u * ((p_ >> 1) ^ (X_ & 1)) + 8u * (p_ & 1); trx[t] = X_ >> 1; }
#define TRA(c_, ks_, t_) (trb[t_] + 8192u * (ks_) + (((unsigned)(c_) ^ trx[t_]) << 5))
#define ST_S1(cn_) do { const int pp_ = (cn_) & 1; LAS unsigned char* const QT_ = F.lds + MC_QT + pp_ * 16384; \
        _Pragma("unroll") for (int hf = 0; hf < 2; ++hf) { f32x4 dv[4]; _Pragma("unroll") for (int cc = 0; cc < 4; ++cc) dv[cc] = *(const LAS f32x4*)(s_d + pp_ * 128 + 16 * (4 * hf + cc) + 4 * g); \
            _Pragma("unroll") for (int j = 0; j < 2; ++j) _Pragma("unroll") for (int cc = 0; cc < 4; ++cc) { const int c8 = 4 * hf + cc; S[j][c8] = S[j][c8] * dv[cc]; \
                *(LAS v2u*)(SP0 + j * 4096 + spoff(l15, 2 * c8 + (g >> 1)) + 8 * (g & 1)) = (v2u){cvtpk(S[j][c8][0], S[j][c8][1]), cvtpk(S[j][c8][2], S[j][c8][3])}; } } \
        bf16x8 sa[2][4]; _Pragma("unroll") for (int j = 0; j < 2; ++j) _Pragma("unroll") for (int ks = 0; ks < 4; ++ks) sa[j][ks] = *(const LAS bf16x8*)(SP0 + j * 4096 + spoff(l15, 4 * ks + g)); \
        _Pragma("unroll") for (int nt = 0; nt < 4; ++nt) { bf16x8 qb[4]; _Pragma("unroll") for (int ks = 0; ks < 4; ++ks) qb[ks] = ldrow(QT_, rra16(lane, nt, ks)); \
            f32x4 a0_ = (f32x4){0.f, 0.f, 0.f, 0.f}, a1_ = (f32x4){0.f, 0.f, 0.f, 0.f}; \
            _Pragma("unroll") for (int ks = 0; ks < 4; ++ks) { a0_ = __builtin_amdgcn_mfma_f32_16x16x32_bf16(sa[0][ks], qb[ks], a0_, 0, 0, 0); a1_ = __builtin_amdgcn_mfma_f32_16x16x32_bf16(sa[1][ks], qb[ks], a1_, 0, 0, 0); } \
            o[0][nt] = a0_; o[1][nt] = a1_; } } while (0)
        YA_ENSURE(0);
        __syncthreads();
        SC_SCORES(0, sw); ST_S1(0);
        __syncthreads();
        for (int c = 0; c < NC; ++c) {
            const int pp = c & 1; LAS unsigned char* const KT = F.lds + MC_KT + pp * 16384;
            asm volatile("" : "+v"(trx[0]), "+v"(trx[1]));
            bf16x8 ivf[2][2];
#pragma unroll
            for (int j = 0; j < 2; ++j)
#pragma unroll
                for (int ks = 0; ks < 2; ++ks) ivf[j][ks] = ldtr(IVI, TRA(2 * sw + j, ks, 0), TRA(2 * sw + j, ks, 1));
#pragma unroll
            for (int nt = 0; nt < 4; ++nt) { bf16x8 pb[2];
#pragma unroll
                for (int ks = 0; ks < 2; ++ks) if (2 * ks <= nt) pb[ks] = *(const LAS bf16x8*)(PB + poff(16 * nt + l15, 4 * ks + g));
#pragma unroll
                for (int ks = 0; ks < 2; ++ks) if (2 * ks <= nt) { o[0][nt] = __builtin_amdgcn_mfma_f32_16x16x32_bf16(ivf[0][ks], pb[ks], o[0][nt], 0, 0, 0); o[1][nt] = __builtin_amdgcn_mfma_f32_16x16x32_bf16(ivf[1][ks], pb[ks], o[1][nt], 0, 0, 0); } }
#pragma unroll
            for (int cc = 0; cc < 8; ++cc) { bf16x8 ka[2];
#pragma unroll
                for (int ks = 0; ks < 2; ++ks) ka[ks] = ldtr(KT, TRA(cc, ks, 0), TRA(cc, ks, 1));
#pragma unroll
                for (int ks = 0; ks < 2; ++ks)
#pragma unroll
                    for (int j = 0; j < 2; ++j) S[j][cc] = __builtin_amdgcn_mfma_f32_16x16x32_bf16(ka[ks], ivf[j][ks], S[j][cc], 0, 0, 0); }
#pragma unroll
            for (int nt = 0; nt < 4; ++nt) { float qs = 0.f;
#pragma unroll
                for (int j = 0; j < 2; ++j) { qs += (o[j][nt][0] * o[j][nt][0] + o[j][nt][1] * o[j][nt][1]) + (o[j][nt][2] * o[j][nt][2] + o[j][nt][3] * o[j][nt][3]);
                    *(LAS v2u*)(OB + zvoff(16 * nt + l15, 4 * sw + 2 * j + (g >> 1)) + 8 * (g & 1)) = (v2u){cvtpk(o[j][nt][0], o[j][nt][1]), cvtpk(o[j][nt][2], o[j][nt][3])}; }
                qs += __shfl_xor(qs, 16); qs += __shfl_xor(qs, 32); if (g == 0) s_sq[(16 * nt + l15) * 4 + sw] = qs; }
            __syncthreads();
            YA_ISSUE(min(c + 2, NC - 1));
            if (c + 1 < NC) { SC_SCORES((c + 1) & 1, sw); ST_S1(c + 1); }
            YA_FINISH(min(c + 2, NC - 1));
            __syncthreads();
        }
#undef ST_S1
#undef YA_ENSURE
#undef YA_ISSUE
#undef YA_FINISH
#undef SC_SCORES
#undef TRA
    }
}

typedef int v2i __attribute__((ext_vector_type(2)));
typedef float v2f __attribute__((ext_vector_type(2)));
__device__ __forceinline__ void phase_final(Frame& F) {
    const KArgs* ap_ = kargs(); const KArgs& a = *ap_; unsigned char* ws = a.ws;
    const float* ada = (const float*)(ws + WS_ADA); const float* gp = a.in[I_GPOSTFFN];
    const int* POS = (const int*)(ws + WS_RANK); const int* EID = (const int*)(ws + WS_EID); const LAS int* s_offs = (const LAS int*)(F.lds + 131072 + 512); const float* EW = (const float*)(ws + WS_EW); const bf16* OUTP = (const bf16*)(ws + WS_OUTP); const bf16* X1B = (const bf16*)(ws + WS_X1);
    const int rows_per = T / F.G, row0 = (int)blockIdx.x * rows_per;
    constexpr int R = 2;
    f32x4 ggt[4];
    { const float* ab = ada + (size_t)(row0 / SEQ) * 6144;
#pragma unroll
      for (int j = 0; j < 4; ++j) { const int c = 256 * j + 4 * F.lane; ggt[j] = *(const f32x4*)(gp + c) * *(const f32x4*)(ab + 5 * D + c); } }
    v2i pp[R], ee[R]; v2f ww[R], cw[R]; v2u u0[R][4], u1[R][4], xb[R][4];
#define FN_POS(i0_) do { _Pragma("unroll") for (int r = 0; r < R; ++r) { const int m = row0 + (i0_) + r * NWAVES; pp[r] = *(const v2i*)(POS + 2 * m); ee[r] = *(const v2i*)(EID + 2 * m); ww[r] = *(const v2f*)(EW + 2 * m); } asm volatile("" ::: "memory"); } while (0)
#define FN_ROWS(i0_) do { _Pragma("unroll") for (int r = 0; r < R; ++r) { const int m = row0 + (i0_) + r * NWAVES; \
            const v2u* r0 = (const v2u*)(OUTP + (size_t)(pp[r].x + s_offs[ee[r].x]) * D) + F.lane; const v2u* r1 = (const v2u*)(OUTP + (size_t)(pp[r].y + s_offs[ee[r].y]) * D) + F.lane; const v2u* xrow = (const v2u*)(X1B + (size_t)m * D) + F.lane; \
            _Pragma("unroll") for (int j = 0; j < 4; ++j) { u0[r][j] = r0[64 * j]; u1[r][j] = r1[64 * j]; xb[r][j] = xrow[64 * j]; } cw[r] = ww[r]; } asm volatile("" ::: "memory"); } while (0)
    const int step = R * NWAVES;
    FN_POS(F.wave); FN_ROWS(F.wave);
    FN_POS((F.wave + step < rows_per) ? F.wave + step : F.wave);
    for (int i0 = F.wave; i0 < rows_per; i0 += step) {
        const int i1 = (i0 + step < rows_per) ? i0 + step : i0, i2 = (i1 + step < rows_per) ? i1 + step : i1;
        f32x4 y[R][4], xo[R][4]; float s[R];
#pragma unroll
        for (int r = 0; r < R; ++r) { float t = 0.f; const float w0 = cw[r].x, w1 = cw[r].y;
#pragma unroll
            for (int j = 0; j < 4; ++j) { const v2u a0 = u0[r][j], a1 = u1[r][j], xx = xb[r][j];
                y[r][j].x = w0 * bf2f(a0.x & 0xffffu) + w1 * bf2f(a1.x & 0xffffu); y[r][j].y = w0 * bf2f(a0.x >> 16) + w1 * bf2f(a1.x >> 16);
                y[r][j].z = w0 * bf2f(a0.y & 0xffffu) + w1 * bf2f(a1.y & 0xffffu); y[r][j].w = w0 * bf2f(a0.y >> 16) + w1 * bf2f(a1.y >> 16);
                xo[r][j] = (f32x4){bf2f(xx.x & 0xffffu), bf2f(xx.x >> 16), bf2f(xx.y & 0xffffu), bf2f(xx.y >> 16)};
                t += (y[r][j].x * y[r][j].x + y[r][j].y * y[r][j].y) + (y[r][j].z * y[r][j].z + y[r][j].w * y[r][j].w); }
            s[r] = t; }
        FN_ROWS(i1);
        FN_POS(i2);
#pragma unroll
        for (int o = 1; o < 64; o <<= 1) {
#pragma unroll
            for (int r = 0; r < R; ++r) s[r] += __shfl_xor(s[r], o); }
#pragma unroll
        for (int r = 0; r < R; ++r) { const int m = row0 + i0 + r * NWAVES;
            const float rr = __builtin_amdgcn_rsqf(s[r] * (1.f / D) + RMS_EPS);
            f32x4* orow = (f32x4*)(a.out + (size_t)m * D) + F.lane;
#pragma unroll
            for (int j = 0; j < 4; ++j) __builtin_nontemporal_store(xo[r][j] + ggt[j] * (y[r][j] * rr), orow + 64 * j); }
    }
#undef FN_POS
#undef FN_ROWS
}

__global__ void __launch_bounds__(NTHREADS, 2) mega(Args args) {
    extern __shared__ __attribute__((aligned(16))) unsigned char lds[];
    Frame F; F.lds = (LAS unsigned char*)lds; F.tid = threadIdx.x; F.lane = F.tid & 63; F.wave = __builtin_amdgcn_readfirstlane(F.tid >> 6);
    F.G = gridDim.x; { const int bx = blockIdx.x; F.vcu = (F.G % 8 == 0) ? (bx % 8) * (F.G / 8) + bx / 8 : bx; }
    volatile LAS unsigned* MISC = (volatile LAS unsigned*)(F.lds + MISC_OFF);
    for (int u = F.tid; u < (LDS_BYTES - 131072) / 4; u += NTHREADS) ((LAS unsigned*)(F.lds + 131072))[u] = 0u;
    __syncthreads();
    XcdBarrier bar = xcd_barrier_post((unsigned*)(args.ws + WS_CTL) + CW_BAR + args.li * XCD_BAR_WORDS, MISC + 8);
    const int lo = args.ph_lo, hi = args.ph_hi;
#define IN(k) (lo <= (k) && (k) < hi)
#define SEAM(k) do { if (IN(k) && IN((k) + 1)) xcd_barrier(bar); } while (0)
#ifndef PROBE_MASK
#define PROBE_MASK 0
#endif
#ifndef PROBE_REPS
#define PROBE_REPS 2
#endif
#define REPS(k) for (int rep_ = 0; rep_ < (((PROBE_MASK >> (k)) & 1) ? PROBE_REPS : 1); ++rep_, (void)((((PROBE_MASK >> (k)) & 1) && rep_ < PROBE_REPS) ? (xcd_barrier(bar), 0) : 0))
    if (IN(PH_PREP)) REPS(PH_PREP) { phase_prep(F); } SEAM(PH_PREP);
    if (IN(PH_HNORM)) REPS(PH_HNORM) { phase_hnorm(F); } SEAM(PH_HNORM);
    unsigned char* const ws = args.ws;
    if (IN(PH_INPROJ)) REPS(PH_INPROJ) {
        pg8::Gemm g{(const bf16*)(ws + WS_H), (const bf16*)(ws + WS_WIN), T, NIN, D}; pg8::StaticOrder S; S.init(T, NIN, F.G, (int)blockIdx.x);
        pg8::EpiInproj E{(bf16*)(ws + WS_GAU), (bf16*)(ws + WS_GBOG), (bf16*)(ws + WS_GV), (bf16*)(ws + WS_QS), (bf16*)(ws + WS_G), (bf16*)(ws + WS_IV), (float*)(ws + WS_VSTAT), (const float*)(ws + WS_LBV)};
        pg8::gemm_phase<pg8::EpiInproj, pg8::StaticOrder, true, true>(F.lds, g, S, E);
    } SEAM(PH_INPROJ);
    if (IN(PH_MIXB)) REPS(PH_MIXB) { phase_mixb(F); } SEAM(PH_MIXB);
    if (IN(PH_OUTPROJ)) REPS(PH_OUTPROJ) {
        pg8::Gemm g{(const bf16*)(ws + WS_H), (const bf16*)(ws + WS_WOUT), T, D, D}; pg8::StaticOrder S; S.init(T, D, F.G, (int)blockIdx.x);
        pg8::EpiBf16 E{(bf16*)(ws + WS_Y2), D};
        pg8::gemm_phase<pg8::EpiBf16, pg8::StaticOrder, true, true>(F.lds, g, S, E);
    } SEAM(PH_OUTPROJ);
    if (IN(PH_ROW1)) REPS(PH_ROW1) { phase_row1(F); } SEAM(PH_ROW1);
    LAS int* s_offs = (LAS int*)(F.lds + 131072 + 512);
    LAS int* s_tot = s_offs + 32;
    if (IN(PH_MOE1) || IN(PH_MOE2) || IN(PH_FINAL)) {
        if (F.tid < NE) s_tot[F.tid] = (int)__hip_atomic_load((unsigned*)(ws + WS_CTL) + CW_TOT + 64 * F.tid, RLX_AGENT);
        __syncthreads();
        if (F.tid == 0) { int o = 0; for (int e = 0; e < NE; ++e) { s_offs[e] = o; o += (s_tot[e] + 255) & ~255; } s_offs[NE] = o; }
        __syncthreads(); }
    unsigned* const pcnt = (unsigned*)(ws + WS_CTL) + CW_PANEL;
    if (IN(PH_MOE1)) {
        pg8::GroupedSignal S; S.init(s_offs, D, F.G, (int)blockIdx.x); S.cnt = pcnt;
        LAS int* s_idx = (LAS int*)(F.lds + 133120);
        { const int* IDXREL = (const int*)(ws + WS_IDXREL);
          int tok[3]; bool have[3];
#pragma unroll
          for (int k = 0; k < 3; ++k) { pg8::Unit u; const int i = 2 * k + (int)(F.tid >> 8); have[k] = S.next(i, u); tok[k] = 0;
              if (have[k]) { const int e = u.pnb / (D / 256), lr = u.pm * 256 - s_offs[e] + (int)(F.tid & 255); if (lr < s_tot[e]) tok[k] = IDXREL[e * 65536 + lr]; } }
#pragma unroll
          for (int k = 0; k < 3; ++k) if (have[k]) s_idx[(2 * k + (int)(F.tid >> 8)) * 256 + (F.tid & 255)] = tok[k];
          __syncthreads(); }
        pg8::Gemm g{(const bf16*)(ws + WS_H2), (const bf16*)(ws + WS_W13), NPMAX, D, D, s_idx};
        pg8::EpiMoe1 E{(bf16*)(ws + WS_ACT), NPMAX * FF * 2};
        pg8::gemm_phase<pg8::EpiMoe1, pg8::GroupedSignal, true, true, true>(F.lds, g, S, E);
    }
    if (IN(PH_MOE1) && !IN(PH_MOE2)) xcd_barrier(bar);
    if (IN(PH_MOE2)) {
        pg8::Gemm g{(const bf16*)(ws + WS_ACT), (const bf16*)(ws + WS_W2), NPMAX, D, FF}; pg8::GroupedWait S; S.init(s_offs, D, F.G, F.G - 1 - (int)blockIdx.x); S.cnt = pcnt; S.need = 8u * (D / 256);
        S.qcnt = (unsigned*)(ws + WS_CTL) + CW_QUEUE; S.xcd = (int)(xb_xcc_id() & 7u); S.slot = (LAS int*)(F.lds + 131072 + 128);
        pg8::EpiBf16 E{(bf16*)(ws + WS_OUTP), D};
        pg8::gemm_phase<pg8::EpiBf16, pg8::GroupedWait, true, true>(F.lds, g, S, E);
    } SEAM(PH_MOE2);
    if (IN(PH_FINAL)) { phase_final(F); }
#undef IN
#undef SEAM
}

template <class Epi, bool PAIRED>
__global__ void __launch_bounds__(256) naive_gemm(const bf16* __restrict__ A, const bf16* __restrict__ Bt, int K, int ntn, const int* __restrict__ offs, size_t estride, Epi E) {
    __shared__ __attribute__((aligned(16))) bf16 sA[64 * 40], sB0[64 * 40], sB1[64 * 40];
    const int bx = blockIdx.x % ntn, by = blockIdx.x / ntn, m0 = by * 64;
    const bf16* Bb = Bt;
    if (offs) { if (m0 >= offs[NE]) return; int e = 0; while (m0 >= offs[e + 1]) ++e; Bb += (size_t)e * estride; }
    int n0a, n0b = 0, pn = 0, cc0 = 0;
    if (PAIRED) { pn = bx >> 1; cc0 = (bx & 1) * 64; n0a = 256 * pn + cc0; n0b = n0a + 128; } else n0a = bx * 64;
    const int tid = threadIdx.x, lane = tid & 63, w = tid >> 6, lr = tid >> 2, lc = (tid & 3) * 8;
    f32x4 acc0[4], acc1[4];
#pragma unroll
    for (int n = 0; n < 4; ++n) { acc0[n] = (f32x4){0.f, 0.f, 0.f, 0.f}; acc1[n] = (f32x4){0.f, 0.f, 0.f, 0.f}; }
    for (int k0 = 0; k0 < K; k0 += 32) {
        *(v4u*)&sA[lr * 40 + lc] = *(const v4u*)&A[(size_t)(m0 + lr) * K + k0 + lc];
        *(v4u*)&sB0[lr * 40 + lc] = *(const v4u*)&Bb[(size_t)(n0a + lr) * K + k0 + lc];
        if (PAIRED) *(v4u*)&sB1[lr * 40 + lc] = *(const v4u*)&Bb[(size_t)(n0b + lr) * K + k0 + lc];
        __syncthreads();
        const bf16x8 av = *(const bf16x8*)&sA[(16 * w + (lane & 15)) * 40 + 8 * (lane >> 4)];
#pragma unroll
        for (int n = 0; n < 4; ++n) {
            const bf16x8 b0 = *(const bf16x8*)&sB0[(16 * n + (lane & 15)) * 40 + 8 * (lane >> 4)];
            acc0[n] = __builtin_amdgcn_mfma_f32_16x16x32_bf16(av, b0, acc0[n], 0, 0, 0);
            if (PAIRED) { const bf16x8 b1 = *(const bf16x8*)&sB1[(16 * n + (lane & 15)) * 40 + 8 * (lane >> 4)];
                acc1[n] = __builtin_amdgcn_mfma_f32_16x16x32_bf16(av, b1, acc1[n], 0, 0, 0); }
        }
        __syncthreads();
    }
#pragma unroll
    for (int n = 0; n < 4; ++n)
#pragma unroll
        for (int r = 0; r < 4; ++r) { const int row = m0 + 16 * w + 4 * (lane >> 4) + r, cin = 16 * n + (lane & 15);
            if (PAIRED) E.pair(row, pn, cc0 + cin, acc0[n][r], acc1[n][r]); else E.one(row, n0a + cin, acc0[n][r]); }
}
struct EpiInprojN { bf16 *GAU, *GBOG, *GV, *QS, *G, *IV; const float* lbv;
    __device__ __forceinline__ void pair(int row, int pn, int cc, float v0, float v1) const {
        const int j = pn >> 2, type = pn & 3, col = 128 * j + cc; const size_t idx = (size_t)row * D + col;
        if (type == 0) GAU[idx] = (bf16)f2bf(gelu_f(v0) * sigmoid_f(v1));
        else if (type == 1) GBOG[idx] = (bf16)f2bf(silu_f(v0) * sigmoid_f(v1));
        else if (type == 2) { GV[idx] = (bf16)f2bf(gelu_f(v0)); QS[idx] = (bf16)f2bf(silu_f(v1)); }
        else { const float lb = lbv[col]; G[idx] = (bf16)f2bf(logf(lb + (1.0f - lb) * sigmoid_f(v0))); IV[idx] = (bf16)f2bf(v1); }
    }
    __device__ __forceinline__ void one(int, int, float) const {}
};
struct EpiF32N { float* C; __device__ __forceinline__ void one(int row, int col, float v) const { C[(size_t)row * D + col] = v; } __device__ __forceinline__ void pair(int, int, int, float, float) const {} };
struct EpiMoe1N { bf16* ACT; __device__ __forceinline__ void pair(int row, int pn, int cc, float v0, float v1) const { ACT[(size_t)row * FF + 128 * pn + cc] = (bf16)f2bf(silu_f(v0) * v1); } __device__ __forceinline__ void one(int, int, float) const {} };
struct EpiBf16N { bf16* C; __device__ __forceinline__ void one(int row, int col, float v) const { C[(size_t)row * D + col] = (bf16)f2bf(v); } __device__ __forceinline__ void pair(int, int, int, float, float) const {} };

__global__ void __launch_bounds__(256) naive_vstat(const bf16* __restrict__ GV, float* __restrict__ VSTAT) {
    const int row = blockIdx.x * 4 + (threadIdx.x >> 6), lane = threadIdx.x & 63;
    float s = 0.f, ss = 0.f;
    for (int c = lane; c < D; c += 64) { const float v = bf2f(GV[(size_t)row * D + c]); s += v; ss += v * v; }
    s = wave_sum(s); ss = wave_sum(ss);
    if (lane < 32) { float* p = VSTAT + ((size_t)row * 32 + lane) * 2; p[0] = lane == 0 ? s : 0.f; p[1] = lane == 0 ? ss : 0.f; }
}

__global__ void __launch_bounds__(256) naive_mixer(Args a) {
    extern __shared__ __attribute__((aligned(16))) unsigned char lds[];
    float* s_vn = (float*)lds;
    float* s_zv = s_vn + 128 * 128;
    float* s_f = s_zv + 128 * 128;
    float* s_op = s_f + 384;
    float* s_red = s_op + 256;
    float* s_mu = s_red + 4;
    unsigned char* ws = a.ws;
    const bf16 *GAU = (const bf16*)(ws + WS_GAU), *GBOG = (const bf16*)(ws + WS_GBOG), *GV = (const bf16*)(ws + WS_GV), *QS = (const bf16*)(ws + WS_QS), *G = (const bf16*)(ws + WS_G), *IV = (const bf16*)(ws + WS_IV);
    const float* VSTAT = (const float*)(ws + WS_VSTAT); bf16* Y = (bf16*)(ws + WS_H);
    const int b = blockIdx.x >> 3, h = blockIdx.x & 7, tid = threadIdx.x, v = tid & 127, kh = tid >> 7, ch = 128 * h + v;
    const float* Wsp = a.in[I_WSP] + (size_t)h * 128 * 128; const float* bsp = a.in[I_BSP] + h * 128;
    const float lng = a.in[I_LNVG][ch], lnb = a.in[I_LNVB][ch], ghg = a.in[I_GHGRN][ch];
    float S[64];
#pragma unroll
    for (int i = 0; i < 64; ++i) S[i] = 0.f;
    for (int n = 0; n < SEQ / 128; ++n) {
        const size_t t0 = (size_t)b * SEQ + 128 * n;
        __syncthreads();
        if (tid < 128) { const float* p = VSTAT + (t0 + tid) * 64; float s = 0.f, ss = 0.f; for (int q = 0; q < 32; ++q) { s += p[2 * q]; ss += p[2 * q + 1]; }
            const float mu = s * (1.f / D), var = ss * (1.f / D) - mu * mu; s_mu[tid] = mu; s_mu[128 + tid] = 1.0f / sqrtf(var + LN_EPS); }
        __syncthreads();
        for (int s = kh; s < 128; s += 2) s_vn[s * 128 + v] = (bf2f(GV[(t0 + s) * D + ch]) - s_mu[s]) * s_mu[128 + s] * lng + lnb;
        __syncthreads();
        for (int t = kh; t < 128; t += 2) { float acc = bsp[t]; const float* wr = Wsp + t * 128;
            for (int s = 0; s <= t; ++s) acc += wr[s] * s_vn[s * 128 + v];
            s_zv[t * 128 + v] = acc; }
        __syncthreads();
        for (int tok = 0; tok < 128; ++tok) {
            const size_t tg = t0 + tok;
            if (tid < 128) { const float f = __expf(bf2f(G[tg * D + ch])); s_f[tid] = f; s_f[128 + tid] = 1.0f - f; s_f[256 + tid] = bf2f(QS[tg * D + ch]); }
            __syncthreads();
            const float iv = bf2f(IV[tg * D + ch]); float part = 0.f;
#pragma unroll
            for (int i = 0; i < 64; ++i) { const int k = 64 * kh + i; S[i] = s_f[k] * S[i] + s_f[128 + k] * iv; part += s_f[256 + k] * S[i]; }
            s_op[kh * 128 + v] = part;
            __syncthreads();
            float o = 0.f;
            if (tid < 128) { o = s_op[v] + s_op[128 + v]; const float sq = wave_sum(o * o); if ((tid & 63) == 0) s_red[tid >> 6] = sq; }
            __syncthreads();
            if (tid < 128) { const float rstd = 1.0f / sqrtf((s_red[0] + s_red[1]) * (1.f / 128.f) + RMS_EPS);
                const float y = bf2f(GAU[tg * D + ch]) * s_zv[tok * 128 + v] + bf2f(GBOG[tg * D + ch]) * (o * rstd * ghg);
                Y[tg * D + ch] = (bf16)f2bf(y); }
        }
    }
}

extern "C" void kernel_launch(void* const* d_in, const int* in_sizes, int n_in, void* d_out, int out_size, void* d_ws, size_t ws_size, hipStream_t stream) {
    static int grid = 0;
    if (grid == 0) {
        if (n_in != 23 || in_sizes[0] != T * D || out_size != T * D || ws_size < WS_END) { fprintf(stderr, "kernel_launch: unexpected shapes / workspace (n_in %d, in0 %d, out %d, ws %zu)\n", n_in, n_in > 0 ? in_sizes[0] : -1, out_size, ws_size); grid = -1; return; }
        int dev = 0, cus = 0;
        if (hipGetDevice(&dev) != hipSuccess || hipDeviceGetAttribute(&cus, hipDeviceAttributeMultiprocessorCount, dev) != hipSuccess) { grid = -1; return; }
        if (hipFuncSetAttribute((const void*)mega, hipFuncAttributeMaxDynamicSharedMemorySize, LDS_BYTES) != hipSuccess) { fprintf(stderr, "kernel_launch: hipFuncSetAttribute(mega) failed\n"); grid = -1; return; }
        if (hipFuncSetAttribute((const void*)naive_mixer, hipFuncAttributeMaxDynamicSharedMemorySize, 140000) != hipSuccess) { fprintf(stderr, "kernel_launch: hipFuncSetAttribute(naive_mixer) failed\n"); grid = -1; return; }
        (void)hipGetLastError();
        grid = cus;
        if (grid != 256) fprintf(stderr, "kernel_launch: %d CUs (built for 256)\n", grid);
    }
    if (grid < 0) return;
    (void)hipMemsetAsync((char*)d_ws + WS_CTL, 0, CTL_ZERO_BYTES, stream);
    Args a{};
    for (int i = 0; i < 23; ++i) a.in[i] = (const float*)d_in[i];
    a.out = (float*)d_out; a.ws = (unsigned char*)d_ws;
    unsigned char* ws = (unsigned char*)d_ws;
    int li = 0;
    auto run = [&](int lo, int hi) { a.ph_lo = lo; a.ph_hi = hi; a.li = li++; hipLaunchKernelGGL(mega, dim3(grid), dim3(NTHREADS), LDS_BYTES, stream, a); };
    run(PH_PREP, PH_N);
}
```

```cpp
#include <hip/hip_runtime.h>
#include <cstdio>
#include <cstdint>

#define GAS __attribute__((address_space(1)))
#define LAS __attribute__((address_space(3)))
typedef unsigned short bf16;
typedef unsigned v4u __attribute__((ext_vector_type(4)));
typedef unsigned v2u __attribute__((ext_vector_type(2)));
typedef float f32x4 __attribute__((ext_vector_type(4)));
typedef float f32x2 __attribute__((ext_vector_type(2)));
typedef short bf16x8 __attribute__((ext_vector_type(8)));
typedef GAS unsigned gu32;

constexpr int D = 1024, BATCH = 16, SEQ = 2048, T = BATCH * SEQ, NIN = 8 * D, NE = 16, FF = 512;
constexpr int NPMAX = 69632;
constexpr float RMS_EPS = 1e-6f, LN_EPS = 1e-5f;
constexpr int NWAVES = 8, NTHREADS = 512;

constexpr size_t MiB = 1u << 20;
constexpr size_t WS_CTL = 0, CTL_ZERO_BYTES = 1 * MiB;
constexpr size_t WS_ADA = 1 * MiB;
constexpr size_t WS_LBV = 2 * MiB;
constexpr size_t WS_HSC = 1 * MiB + 512 * 1024;
constexpr size_t WS_WSC = 1 * MiB + 896 * 1024;
constexpr int CW_ABS = 62592;
constexpr size_t WS_WSC13 = 1 * MiB + 768 * 1024;
constexpr size_t WS_SCREL = 8 * MiB;
constexpr size_t WS_CNT = 2 * MiB + 64 * 1024;
constexpr size_t WS_OFFS = 2 * MiB + 96 * 1024;
constexpr size_t WS_EID = 2 * MiB + 128 * 1024;
constexpr size_t WS_EW = WS_EID + 256 * 1024;
constexpr size_t WS_RANK = WS_EW + 256 * 1024;
constexpr size_t WS_POS = WS_RANK + 256 * 1024;
constexpr size_t WS_IDX = 3 * MiB + 256 * 1024;
constexpr size_t WS_VSTAT = 4 * MiB;
constexpr size_t WS_IDXREL = 4 * MiB;
constexpr int CW_QUEUE = 61440;
constexpr int CW_ADA1 = 62464;
constexpr int CW_PANEL = 32768;
constexpr int CW_TOT = 2048;
constexpr size_t WS_WIN = 12 * MiB;
constexpr size_t WS_WOUT = 28 * MiB;
constexpr size_t WS_H = 32 * MiB;
constexpr size_t WS_GAU = 96 * MiB, WS_GBOG = 160 * MiB, WS_GV = 224 * MiB, WS_QS = 288 * MiB, WS_G = 352 * MiB, WS_IV = 416 * MiB;
constexpr size_t WS_Y2 = 96 * MiB;
constexpr size_t WS_X1 = 336 * MiB;
constexpr size_t WS_H2 = 400 * MiB;
constexpr size_t WS_W13 = 480 * MiB;
constexpr size_t WS_W2 = 12 * MiB;
constexpr size_t WS_H2P = 336 * MiB;
constexpr size_t WS_ACT = 96 * MiB;
constexpr size_t WS_OUTP = 164 * MiB;
constexpr size_t WS_END = 512 * MiB;

constexpr int LDS_BYTES = 155648;
constexpr int MISC_OFF = 131072 + 320;

#define RLX_AGENT __ATOMIC_RELAXED, __HIP_MEMORY_SCOPE_AGENT
#define LDS_WAIT() asm volatile("s_waitcnt lgkmcnt(0)" ::: "memory")
__device__ __forceinline__ unsigned f2bf(float f) { unsigned u = __builtin_bit_cast(unsigned, f); return (u + 0x7fffu + ((u >> 16) & 1u)) >> 16; }
typedef __bf16 bf16x2_hw __attribute__((ext_vector_type(2)));
typedef float f32x2_hw __attribute__((ext_vector_type(2)));
__device__ __forceinline__ unsigned pk2(float lo, float hi) { const f32x2_hw v = {lo, hi}; return __builtin_bit_cast(unsigned, __builtin_convertvector(v, bf16x2_hw)); }
__device__ __forceinline__ float bf2f(unsigned b) { return __builtin_bit_cast(float, b << 16); }
__device__ __forceinline__ float sigmoid_f(float z) { return 1.0f / (1.0f + __expf(-z)); }
__device__ __forceinline__ float gelu_f(float x) { return x * sigmoid_f(1.5957691216057308f * (x + 0.044715f * x * x * x)); }
__device__ __forceinline__ float silu_f(float x) { return x * sigmoid_f(x); }
__device__ __forceinline__ float wave_sum(float v) {
#pragma unroll
    for (int o = 1; o < 64; o <<= 1) v += __shfl_xor(v, o);
    return v;
}

namespace pg8 {
#define PG8_LAS __attribute__((address_space(3)))
typedef unsigned short bf16_t;
typedef short bf16x8 __attribute__((ext_vector_type(8)));
typedef float f32x4 __attribute__((ext_vector_type(4)));
typedef unsigned u32x4 __attribute__((ext_vector_type(4)));
constexpr int SCL_SLOT = 2560;
constexpr int SCL_OFF = 143360;
constexpr int BM = 256, BK = 64, HALF = 128, HTB = HALF * BK * 2  , STAGE_BYTES = 8 * HTB, NXCD = 8, WGM = 8;

__host__ __device__ __forceinline__ int lds_byte(int r, int c) { const int st = (r >> 4) * 2 + (c >> 5), rr = r & 15, cc = c & 31, ob = rr * 64 + cc * 2; return st * 1024 + (ob ^ (((ob >> 9) & 1) << 5)); }
__host__ __device__ __forceinline__ void stage_rc(int b, int& R, int& C) { const int st = b / 1024, sb = b % 1024, swz = sb ^ (((sb >> 9) & 1) << 5); R = (st >> 1) * 16 + swz / 64; C = (st & 1) * 32 + (swz % 64) / 2; }
__host__ __device__ __forceinline__ int perm32(int rho) { const int n = rho >> 4, i = rho & 15; return 8 * (i >> 2) + 4 * n + (i & 3); }

struct Unit { int pm, pn, pnb; };
struct Gemm { const bf16_t* A; const bf16_t* Bt; int M, N, K; const PG8_LAS int* sidx; };

struct StaticOrder {
    int nM, nN, nwg, G, c, rot4 = 0;
    __host__ __device__ void init(int M, int N, int G_, int c_) { nM = M / BM; nN = N / BM; nwg = nM * nN; G = G_; c = c_; }
    __host__ __device__ bool next(int i, Unit& u) const {
        const long L = (long)i * G + c; if (L >= nwg) return false;
        int wgid = (int)L; { const int q = nwg / NXCD, r = nwg % NXCD, xcd = wgid % NXCD, off = wgid / NXCD; wgid = (xcd < r ? xcd * (q + 1) : r * (q + 1) + (xcd - r) * q) + off; }
        const int nig = WGM * nN, gid = wgid / nig, fm = gid * WGM, gsz = (nM - fm) < WGM ? (nM - fm) : WGM;
        u.pm = fm + ((wgid % nig) % gsz); u.pn = (wgid % nig) / gsz; if (rot4) u.pn = (u.pn & ~3) | ((u.pn + i) & 3); u.pnb = u.pn; return true;
    }
    __device__ __forceinline__ void a_ready(const Unit&) const {}
    __device__ __forceinline__ void done(const Unit&) const {}
    __device__ __forceinline__ void done_deferred(const Unit&) const {}
};

typedef float f32x2 __attribute__((ext_vector_type(2)));

typedef __bf16 bf16x2_t __attribute__((ext_vector_type(2)));
__device__ __forceinline__ unsigned cvt_pk_bf16(float lo, float hi) { const f32x2 v = {lo, hi}; const bf16x2_t b = __builtin_convertvector(v, bf16x2_t); return __builtin_bit_cast(unsigned, b); }
__device__ __forceinline__ float ex2(float x) { return __builtin_amdgcn_exp2f(x); }
__device__ __forceinline__ float rcp(float x) { return __builtin_amdgcn_rcpf(x); }
constexpr float L2E = 1.4426950408889634f, GK = 1.5957691216057308f * 1.4426950408889634f;
__device__ __forceinline__ f32x2 ex2v(f32x2 x) { return (f32x2){__builtin_amdgcn_exp2f(x.x), __builtin_amdgcn_exp2f(x.y)}; }
__device__ __forceinline__ f32x2 rcpv(f32x2 x) { return (f32x2){__builtin_amdgcn_rcpf(x.x), __builtin_amdgcn_rcpf(x.y)}; }
__device__ __forceinline__ f32x2 gelu_argv(f32x2 x) { return (x + (0.044715f * x) * (x * x)) * (-1.5957691216057308f * 1.4426950408889634f); }
__device__ __forceinline__ float gelu_arg(float x) { return -GK * (x + 0.044715f * x * x * x); }
__device__ __forceinline__ u32x4 pack8(const float (&o)[8]) { u32x4 w; w.x = cvt_pk_bf16(o[0], o[1]); w.y = cvt_pk_bf16(o[2], o[3]); w.z = cvt_pk_bf16(o[4], o[5]); w.w = cvt_pk_bf16(o[6], o[7]); return w; }

__device__ __forceinline__ int f2i(float f) { return __builtin_bit_cast(int, f); }
struct EpiInproj {
    static constexpr bool PERM = true, AFTER_DRAIN = false, PRESCALE = false, SPLIT_BAR = false;
    bf16_t *GAU, *GBOG, *GV, *QS, *G, *IV; float* VSTAT; const float* lbv;
    __device__ __forceinline__ void operator()(const f32x4 (&acc)[2][2][4][2], const Unit& u, int wr, int wc, int fr, int fq) const {
        const int j = u.pn >> 2, type = u.pn & 3, row0 = u.pm * BM + wr * 64 + fr, col0 = 128 * j + wc * 32 + 8 * fq;
        float lb[8];
        if (type == 3) { const f32x4 l0 = *(const f32x4*)(lbv + col0), l1 = *(const f32x4*)(lbv + col0 + 4); lb[0] = l0[0]; lb[1] = l0[1]; lb[2] = l0[2]; lb[3] = l0[3]; lb[4] = l1[0]; lb[5] = l1[1]; lb[6] = l1[2]; lb[7] = l1[3]; }
        else {
#pragma unroll
            for (int i = 0; i < 8; ++i) lb[i] = 0.f; }
#pragma unroll
        for (int ai = 0; ai < 2; ++ai)
#pragma unroll
            for (int m = 0; m < 4; ++m) {
                const int row = row0 + ai * HALF + m * 16; const size_t off = ((size_t)(row >> 4) * 32 + (col0 >> 5)) * 512 + (row & 15) * 32 + (col0 & 31);
                float a[8], b[8], o[8];
#pragma unroll
                for (int i = 0; i < 4; ++i) { a[i] = acc[ai][0][m][0][i]; a[4 + i] = acc[ai][0][m][1][i]; b[i] = acc[ai][1][m][0][i]; b[4 + i] = acc[ai][1][m][1][i]; }
                if (type == 0) {
#pragma unroll
                    for (int i = 0; i < 8; ++i) o[i] = a[i] * rcp((1.0f + ex2(gelu_arg(a[i]))) * (1.0f + ex2(-L2E * b[i])));
                    *(u32x4*)(GAU + off) = pack8(o);
                } else if (type == 1) {
#pragma unroll
                    for (int i = 0; i < 8; ++i) o[i] = a[i] * rcp((1.0f + ex2(-L2E * a[i])) * (1.0f + ex2(-L2E * b[i])));
                    __builtin_nontemporal_store(pack8(o), (u32x4*)(GBOG + off));
                } else if (type == 2) {
                    float s = 0.f, ss = 0.f;
#pragma unroll
                    for (int i = 0; i < 8; ++i) { o[i] = a[i] * rcp(1.0f + ex2(gelu_arg(a[i]))); s += o[i]; ss += o[i] * o[i]; }
                    *(u32x4*)(GV + off) = pack8(o);
#pragma unroll
                    for (int i = 0; i < 8; ++i) o[i] = b[i] * rcp(1.0f + ex2(-L2E * b[i]));
                    __builtin_nontemporal_store(pack8(o), (u32x4*)(QS + off));
                    s += __shfl_xor(s, 16); ss += __shfl_xor(ss, 16); s += __shfl_xor(s, 32); ss += __shfl_xor(ss, 32);
                    if (fq == 0) *(f32x2*)(VSTAT + ((size_t)row * 32 + 4 * j + wc) * 2) = (f32x2){s, ss};
                } else {
#pragma unroll
                    for (int i = 0; i < 8; ++i) { const float sg = rcp(1.0f + ex2(-L2E * a[i])); o[i] = 0.6931471805599453f * __builtin_amdgcn_logf(lb[i] + (1.0f - lb[i]) * sg); }
                    __builtin_nontemporal_store(pack8(o), (u32x4*)(G + off));
                    __builtin_nontemporal_store(pack8(b), (u32x4*)(IV + off));
                }
            }
    }
};
struct EpiInproj8 {
    static constexpr bool PERM = true, AFTER_DRAIN = false, PRESCALE = true, SPLIT_BAR = true;
    bf16_t *GAU, *GBOG, *GV, *QS, *G, *IV; float* VSTAT; const float* lbv; const float* rsc; const float* csc;
    __device__ __forceinline__ void prefetch(const Unit& u, PG8_LAS unsigned char* slot, int wid, int lane) const {
        const float* src = wid < 4 ? rsc + u.pm * BM + 64 * wid + lane : csc + 256 * u.pn + 64 * (wid - 4) + lane;
        __builtin_amdgcn_global_load_lds((const unsigned*)src, (PG8_LAS unsigned*)(slot + wid * 256), 4, 0, 0);
        if ((u.pn & 3) == 3 && wid >= 6)
            __builtin_amdgcn_global_load_lds((const unsigned*)(lbv + 128 * (u.pn >> 2) + 64 * (wid - 6) + lane), (PG8_LAS unsigned*)(slot + 2048 + (wid - 6) * 256), 4, 0, 0);
    }
    template <int TY> __device__ __forceinline__ void run(const f32x4 (&acc)[2][2][4][2], const float (&rs8)[2][4], const f32x4 ca0, const f32x4 ca1, const f32x4 cb0, const f32x4 cb1, const float (&lb)[8],
                                                          int row0, int col0, int j, int wc, int fq, int wr) const {
        const f32x4 xb0 = TY <= 1 ? cb0 * (-L2E) : cb0, xb1 = TY <= 1 ? cb1 * (-L2E) : cb1;
        f32x2 om[4];
#pragma unroll
        for (int i = 0; i < 4; ++i) om[i] = 1.0f - (f32x2){lb[2 * i], lb[2 * i + 1]};
#pragma unroll
        for (int ai = 0; ai < 2; ++ai)
#pragma unroll
            for (int m = 0; m < 4; ++m) {
                const int row = row0 + ai * HALF + m * 16; const size_t off = ((size_t)(row >> 4) * 32 + (col0 >> 5)) * 512 + (row & 15) * 32 + (col0 & 31);
                float a[8], b[8], o[8]; const float rs = rs8[ai][m];
#pragma unroll
                for (int i = 0; i < 4; ++i) { a[i] = (float)f2i(acc[ai][0][m][0][i]) * (rs * ca0[i]); a[4 + i] = (float)f2i(acc[ai][0][m][1][i]) * (rs * ca1[i]);
                    b[i] = (float)f2i(acc[ai][1][m][0][i]) * (rs * xb0[i]); b[4 + i] = (float)f2i(acc[ai][1][m][1][i]) * (rs * xb1[i]); }
                if constexpr (TY == 0) {
#pragma unroll
                    for (int i = 0; i < 4; ++i) { const f32x2 av = {a[2 * i], a[2 * i + 1]}, bv = {b[2 * i], b[2 * i + 1]};
                        const f32x2 ov = av * rcpv((ex2v(gelu_argv(av)) + 1.0f) * (ex2v(bv) + 1.0f)); o[2 * i] = ov.x; o[2 * i + 1] = ov.y; }
                    __builtin_nontemporal_store(pack8(o), (u32x4*)(GAU + off));
                } else if constexpr (TY == 1) {
#pragma unroll
                    for (int i = 0; i < 4; ++i) { const f32x2 av = {a[2 * i], a[2 * i + 1]}, bv = {b[2 * i], b[2 * i + 1]};
                        const f32x2 ov = av * rcpv((ex2v(av * (-L2E)) + 1.0f) * (ex2v(bv) + 1.0f)); o[2 * i] = ov.x; o[2 * i + 1] = ov.y; }
                    __builtin_nontemporal_store(pack8(o), (u32x4*)(GBOG + off));
                } else if constexpr (TY == 2) {
                    f32x2 sv = {0.f, 0.f}, ssv = {0.f, 0.f};
#pragma unroll
                    for (int i = 0; i < 4; ++i) { const f32x2 av = {a[2 * i], a[2 * i + 1]}; const f32x2 ov = av * rcpv(ex2v(gelu_argv(av)) + 1.0f); o[2 * i] = ov.x; o[2 * i + 1] = ov.y; sv += ov; ssv += ov * ov; }
                    float s = sv.x + sv.y, ss = ssv.x + ssv.y;
                    __builtin_nontemporal_store(pack8(o), (u32x4*)(GV + off));
#pragma unroll
                    for (int i = 0; i < 4; ++i) { const f32x2 bv = {b[2 * i], b[2 * i + 1]}; const f32x2 ov = bv * rcpv(ex2v(bv * (-L2E)) + 1.0f); o[2 * i] = ov.x; o[2 * i + 1] = ov.y; }
                    __builtin_nontemporal_store(pack8(o), (u32x4*)(QS + off));
                    s += __shfl_xor(s, 16); ss += __shfl_xor(ss, 16); s += __shfl_xor(s, 32); ss += __shfl_xor(ss, 32);
                    if (fq == 0) *(f32x2*)(VSTAT + ((size_t)row * 32 + 4 * j + wc) * 2) = (f32x2){s, ss};
                } else {
#pragma unroll
                    for (int i = 0; i < 4; ++i) { const f32x2 av = {a[2 * i], a[2 * i + 1]}, lv = {lb[2 * i], lb[2 * i + 1]}; const f32x2 sg = rcpv(ex2v(av * (-L2E)) + 1.0f), ar = lv + om[i] * sg;
                        const f32x2 ov = (f32x2){__builtin_amdgcn_logf(ar.x), __builtin_amdgcn_logf(ar.y)} * 0.6931471805599453f; o[2 * i] = ov.x; o[2 * i + 1] = ov.y; }
                    __builtin_nontemporal_store(pack8(o), (u32x4*)(G + off));
                    __builtin_nontemporal_store(pack8(b), (u32x4*)(IV + off));
                }
                if (ai == 0 && m == 0) { if (wr == 0) __builtin_amdgcn_s_barrier(); }
            }
    }
    __device__ __forceinline__ void operator()(const f32x4 (&acc)[2][2][4][2], const Unit& u, int wr, int wc, int fr, int fq, const PG8_LAS unsigned char* slot) const {
        const int j = u.pn >> 2, type = u.pn & 3, row0 = u.pm * BM + wr * 64 + fr, col0 = 128 * j + wc * 32 + 8 * fq;
        const PG8_LAS float* cs = (const PG8_LAS float*)(slot + 1024) + 32 * wc + 8 * fq;
        const f32x4 ca0 = *(const PG8_LAS f32x4*)(cs), ca1 = *(const PG8_LAS f32x4*)(cs + 4), cb0 = *(const PG8_LAS f32x4*)(cs + 128), cb1 = *(const PG8_LAS f32x4*)(cs + 132);
        float rs8[2][4];
#pragma unroll
        for (int ai = 0; ai < 2; ++ai)
#pragma unroll
            for (int m = 0; m < 4; ++m) rs8[ai][m] = ((const PG8_LAS float*)slot)[wr * 64 + fr + ai * HALF + m * 16];
        float lb[8];
        if (type == 3) { const PG8_LAS float* lp = (const PG8_LAS float*)(slot + 2048) + 32 * wc + 8 * fq; const f32x4 l0 = *(const PG8_LAS f32x4*)(lp), l1 = *(const PG8_LAS f32x4*)(lp + 4); lb[0] = l0[0]; lb[1] = l0[1]; lb[2] = l0[2]; lb[3] = l0[3]; lb[4] = l1[0]; lb[5] = l1[1]; lb[6] = l1[2]; lb[7] = l1[3]; }
        else {
#pragma unroll
            for (int i = 0; i < 8; ++i) lb[i] = 0.f; }
        if (type == 0) run<0>(acc, rs8, ca0, ca1, cb0, cb1, lb, row0, col0, j, wc, fq, wr); else if (type == 1) run<1>(acc, rs8, ca0, ca1, cb0, cb1, lb, row0, col0, j, wc, fq, wr);
        else if (type == 2) run<2>(acc, rs8, ca0, ca1, cb0, cb1, lb, row0, col0, j, wc, fq, wr); else run<3>(acc, rs8, ca0, ca1, cb0, cb1, lb, row0, col0, j, wc, fq, wr);
    }
};
struct EpiF32 {
    static constexpr bool PERM = false, AFTER_DRAIN = false, PRESCALE = false, SPLIT_BAR = false;
    float* C; int ldc;
    __device__ __forceinline__ void operator()(const f32x4 (&acc)[2][2][4][2], const Unit& u, int wr, int wc, int fr, int fq) const {
        const int row0 = u.pm * BM + wr * 64 + fr, col0 = u.pn * BM + wc * 32 + 4 * fq;
#pragma unroll
        for (int ai = 0; ai < 2; ++ai)
#pragma unroll
            for (int m = 0; m < 4; ++m) { float* rowp = C + (size_t)(row0 + ai * HALF + m * 16) * ldc + col0;
#pragma unroll
                for (int bj = 0; bj < 2; ++bj)
#pragma unroll
                    for (int n = 0; n < 2; ++n) *(f32x4*)(rowp + bj * HALF + n * 16) = acc[ai][bj][m][n]; }
    }
};
struct EpiMoe1 {
    static constexpr bool PERM = true, AFTER_DRAIN = false, PRESCALE = false, SPLIT_BAR = false;
    bf16_t* ACT; int act_bytes;
    __device__ __forceinline__ void operator()(const f32x4 (&acc)[2][2][4][2], const Unit& u, int wr, int wc, int fr, int fq) const {
        const int row0 = u.pm * BM + wr * 64 + fr, col0 = 128 * u.pn + wc * 32 + 8 * fq;
        const __amdgpu_buffer_rsrc_t rs = __builtin_amdgcn_make_buffer_rsrc(ACT, 0, act_bytes, 0x00020000);
#pragma unroll
        for (int ai = 0; ai < 2; ++ai)
#pragma unroll
            for (int m = 0; m < 4; ++m) { float o[8];
#pragma unroll
                for (int i = 0; i < 4; ++i) { const float a0 = acc[ai][0][m][0][i], a1 = acc[ai][0][m][1][i];
                    o[i] = a0 * acc[ai][1][m][0][i] * rcp(1.0f + ex2(-L2E * a0)); o[4 + i] = a1 * acc[ai][1][m][1][i] * rcp(1.0f + ex2(-L2E * a1)); }
                __builtin_amdgcn_raw_buffer_store_b128(pack8(o), rs, (unsigned)(((row0 + ai * HALF + m * 16) * 512 + col0) * 2), 0,   16); }
    }
};
struct EpiMoe1I8 {
    static constexpr bool PERM = true, AFTER_DRAIN = false, PRESCALE = true, SPLIT_BAR = true;
    bf16_t* ACT; int act_bytes; const float* screl; const float* wsc; const PG8_LAS int* offs; const PG8_LAS int* tot;
    __device__ __forceinline__ void prefetch(const Unit& u, PG8_LAS unsigned char* slot, int wid, int lane) const {
        const int e = u.pnb >> 2;
        const float* src = wid < 4 ? screl + (size_t)e * 65536 + (u.pm * BM - offs[e]) + 64 * wid + lane : wsc + 1024 * e + 256 * u.pn + 64 * (wid - 4) + lane;
        __builtin_amdgcn_global_load_lds((const unsigned*)src, (PG8_LAS unsigned*)(slot + wid * 256), 4, 0, 0);
    }
    __device__ __forceinline__ void operator()(const f32x4 (&acc)[2][2][4][2], const Unit& u, int wr, int wc, int fr, int fq, const PG8_LAS unsigned char* slot) const {
        const int row0 = u.pm * BM + wr * 64 + fr, col0 = 128 * u.pn + wc * 32 + 8 * fq, e = u.pnb >> 2;
        const __amdgpu_buffer_rsrc_t rs = __builtin_amdgcn_make_buffer_rsrc(ACT, 0, act_bytes, 0x00020000);
        const int lo = offs[e], nt_ = tot[e];
        const PG8_LAS float* cs = (const PG8_LAS float*)(slot + 1024) + 32 * wc + 8 * fq;
        const f32x4 ca0 = *(const PG8_LAS f32x4*)(cs), ca1 = *(const PG8_LAS f32x4*)(cs + 4), cb0 = *(const PG8_LAS f32x4*)(cs + 128), cb1 = *(const PG8_LAS f32x4*)(cs + 132);
        float rs8[2][4];
#pragma unroll
        for (int ai = 0; ai < 2; ++ai)
#pragma unroll
            for (int m = 0; m < 4; ++m) { const int p_ = row0 + ai * HALF + m * 16; const float v_ = ((const PG8_LAS float*)slot)[wr * 64 + fr + ai * HALF + m * 16]; rs8[ai][m] = (p_ - lo < nt_) ? v_ : 0.f; }
#pragma unroll
        for (int ai = 0; ai < 2; ++ai)
#pragma unroll
            for (int m = 0; m < 4; ++m) { float o[8]; const int p = row0 + ai * HALF + m * 16; const float rsc = rs8[ai][m];
#pragma unroll
                for (int i = 0; i < 2; ++i) {
                    const f32x2 a0 = (f32x2){(float)f2i(acc[ai][0][m][0][2 * i]), (float)f2i(acc[ai][0][m][0][2 * i + 1])} * (rsc * (f32x2){ca0[2 * i], ca0[2 * i + 1]});
                    const f32x2 a1 = (f32x2){(float)f2i(acc[ai][0][m][1][2 * i]), (float)f2i(acc[ai][0][m][1][2 * i + 1])} * (rsc * (f32x2){ca1[2 * i], ca1[2 * i + 1]});
                    const f32x2 b0 = (f32x2){(float)f2i(acc[ai][1][m][0][2 * i]), (float)f2i(acc[ai][1][m][0][2 * i + 1])} * (rsc * (f32x2){cb0[2 * i], cb0[2 * i + 1]});
                    const f32x2 b1 = (f32x2){(float)f2i(acc[ai][1][m][1][2 * i]), (float)f2i(acc[ai][1][m][1][2 * i + 1])} * (rsc * (f32x2){cb1[2 * i], cb1[2 * i + 1]});
                    const f32x2 o0 = a0 * b0 * rcpv(ex2v(a0 * (-L2E)) + 1.0f), o1 = a1 * b1 * rcpv(ex2v(a1 * (-L2E)) + 1.0f);
                    o[2 * i] = o0.x; o[2 * i + 1] = o0.y; o[4 + 2 * i] = o1.x; o[4 + 2 * i + 1] = o1.y; }
                __builtin_amdgcn_raw_buffer_store_b128(pack8(o), rs, (unsigned)((p * 512 + col0) * 2), 0,   16);
                if (ai == 0 && m == 0) { if (wr == 0) __builtin_amdgcn_s_barrier(); } }
    }
};
struct EpiBf16 {
    static constexpr bool PERM = true, AFTER_DRAIN = false, PRESCALE = false, SPLIT_BAR = true;
    bf16_t* O; int ldc;
    __device__ __forceinline__ void operator()(const f32x4 (&acc)[2][2][4][2], const Unit& u, int wr, int wc, int fr, int fq) const {
        const int row0 = u.pm * BM + wr * 64 + fr, col0 = u.pn * BM + wc * 32 + 8 * fq;
#pragma unroll
        for (int ai = 0; ai < 2; ++ai)
#pragma unroll
            for (int m = 0; m < 4; ++m) { bf16_t* rowp = O + (size_t)(row0 + ai * HALF + m * 16) * ldc + col0;
#pragma unroll
                for (int bj = 0; bj < 2; ++bj) { const f32x4 v0 = acc[ai][bj][m][0], v1 = acc[ai][bj][m][1]; u32x4 w;
                    w.x = cvt_pk_bf16(v0[0], v0[1]); w.y = cvt_pk_bf16(v0[2], v0[3]); w.z = cvt_pk_bf16(v1[0], v1[1]); w.w = cvt_pk_bf16(v1[2], v1[3]);
                    *(u32x4*)(rowp + bj * HALF) = w; }
                if (ai == 0 && m == 0) { if (wr == 0) __builtin_amdgcn_s_barrier(); } }
    }
};
struct GroupedOrder {
    const PG8_LAS int* offs; int nN, nwg, G, c;
    __device__ void init(const PG8_LAS int* offs_, int N, int G_, int c_) { offs = offs_; nN = N / BM; nwg = (offs_[16] / BM) * nN; G = G_; c = c_; }
    __device__ bool next(int i, Unit& u) const { return unit_of((long)i * G + c, u); }
    __device__ bool unit_of(const long L, Unit& u) const {
        if (L >= nwg) return false;
        int wgid = (int)L; { const int q = nwg / NXCD, r = nwg % NXCD, xcd = wgid % NXCD, off = wgid / NXCD; wgid = (xcd < r ? xcd * (q + 1) : r * (q + 1) + (xcd - r) * q) + off; }
        u.pm = wgid / nN; u.pn = wgid % nN; const int row = u.pm * BM; int e = 0;
#pragma unroll
        for (int k = 1; k < 16; ++k) e += (row >= offs[k]) ? 1 : 0;
        u.pnb = e * nN + u.pn; return true;
    }
    __device__ __forceinline__ void a_ready(const Unit&) const {}
    __device__ __forceinline__ void done(const Unit&) const {}
    __device__ __forceinline__ void done_deferred(const Unit&) const {}
};
struct GroupedSignal : GroupedOrder {
    unsigned* cnt;
    __device__ __forceinline__ void done_deferred(const Unit& u) const { if ((threadIdx.x & 63) == 0) (void)__hip_atomic_fetch_add(cnt + 64 * u.pm, 1u, __ATOMIC_RELAXED, __HIP_MEMORY_SCOPE_AGENT); }
};
struct GroupedWait : GroupedOrder {
    const unsigned* cnt; unsigned need;
    unsigned* qcnt; int xcd; PG8_LAS int* slot;
    __device__ bool next(int i, Unit& u) const {
        PG8_LAS int* sl = slot + (i & 1);
        if (threadIdx.x == 0) { int L = -1;
            for (int k = 0; k < NXCD; ++k) { const int q = (xcd + k) & (NXCD - 1); const int t = (int)__hip_atomic_fetch_add(qcnt + 64 * q, 1u, __ATOMIC_RELAXED, __HIP_MEMORY_SCOPE_AGENT); const int l = q + NXCD * t; if (l < nwg) { L = l; break; } }
            *(volatile PG8_LAS int*)sl = L; }
        asm volatile("s_waitcnt lgkmcnt(0)" ::: "memory"); __builtin_amdgcn_s_barrier(); asm volatile("" ::: "memory");
        const int L = *(volatile PG8_LAS int*)sl;
        if (L < 0) return false; return unit_of(L, u);
    }
    __device__ __forceinline__ void a_ready(const Unit& u) const {
        if (threadIdx.x < 64) { unsigned sp = 0;
            while ((unsigned)__builtin_amdgcn_readfirstlane((int)__hip_atomic_load(cnt + 64 * u.pm, __ATOMIC_RELAXED, __HIP_MEMORY_SCOPE_AGENT)) < need) { __builtin_amdgcn_s_sleep(2); if (++sp > (1u << 22)) break; }
            __builtin_amdgcn_fence(__ATOMIC_ACQUIRE, "agent");
            asm volatile("s_waitcnt vmcnt(0)" ::: "memory"); }
        asm volatile("" ::: "memory"); __builtin_amdgcn_s_barrier(); asm volatile("" ::: "memory");
    }
};
typedef int i32x4 __attribute__((ext_vector_type(4)));
template <class Epi, class Sched, bool ALIGN_EPI = false, bool SP2 = false, bool GATHER = false, bool I8 = false>
__device__ __forceinline__ void gemm_phase(PG8_LAS unsigned char* lds, const Gemm g, const Sched& S, const Epi& E) {
    const int tid = threadIdx.x, wid = __builtin_amdgcn_readfirstlane(tid >> 6), lane = tid & 63, wr = wid >> 2, wc = wid & 3, fr = lane & 15, fq = lane >> 4;
    const int K = g.K, nt = K / BK;
    unsigned voffA[2], voffB[2];
#pragma unroll
    for (int i = 0; i < 2; ++i) { int R, C; stage_rc(tid * 16 + i * 8192, R, C); const int Rb = Epi::PERM ? ((R & ~31) + perm32(R & 31)) : R;
        voffA[i] = (unsigned)(R * K + C) * 2u; voffB[i] = (unsigned)(Rb * K + C) * 2u; }
    const size_t kstep = (size_t)(BK * 2);
    const size_t hstep = (size_t)HALF * K * 2;
    const size_t tstep = 2 * hstep;
    const unsigned ldsw = (unsigned)wid * 1024u;
    const int aoff = lds_byte(wr * 64 + fr, fq * 8), boff = lds_byte(wc * 32 + fr, fq * 8);
#define PG8_SA(b, h) (((b) * 2 + (h)) * HTB)
#define PG8_SB(b, h) ((4 + (b) * 2 + (h)) * HTB)
#define PG8_STAGE(bufoff, gbase, voff) do { _Pragma("unroll") for (int _i = 0; _i < 2; ++_i) \
        __builtin_amdgcn_global_load_lds((const unsigned*)((const char*)(gbase) + (voff)[_i]), (PG8_LAS unsigned*)(lds + (bufoff) + ldsw + _i * 8192), 16, 0, 0); } while (0)
#define PG8_STAGE_A(bufoff, gbase, half, selnext) do { if constexpr (GATHER) { unsigned vo_[2]; vo_[0] = (selnext) ? nv[half][0] : cv[half][0]; vo_[1] = (selnext) ? nv[half][1] : cv[half][1]; PG8_STAGE(bufoff, gbase, vo_); } \
        else { PG8_STAGE(bufoff, (gbase) + (half) * hstep, voffA); } } while (0)
#define PG8_LDA(dst, b, h) do { _Pragma("unroll") for (int m = 0; m < 4; ++m) _Pragma("unroll") for (int k = 0; k < 2; ++k) dst[m][k] = *(const PG8_LAS bf16x8*)(lds + PG8_SA(b, h) + aoff + m * 2048 + k * 1024); } while (0)
#define PG8_LDB(dst, b, h) do { _Pragma("unroll") for (int n = 0; n < 2; ++n) _Pragma("unroll") for (int k = 0; k < 2; ++k) dst[n][k] = *(const PG8_LAS bf16x8*)(lds + PG8_SB(b, h) + boff + n * 2048 + k * 1024); } while (0)
#define PG8_MMA(ai, bj, At, Bt) do { __builtin_amdgcn_s_setprio(1); _Pragma("unroll") for (int m = 0; m < 4; ++m) _Pragma("unroll") for (int n = 0; n < 2; ++n) _Pragma("unroll") for (int k = 0; k < 2; ++k) \
        { if constexpr (I8) acc[ai][bj][m][n] = __builtin_bit_cast(f32x4, __builtin_amdgcn_mfma_i32_16x16x64_i8(__builtin_bit_cast(i32x4, Bt[n][k]), __builtin_bit_cast(i32x4, At[m][k]), __builtin_bit_cast(i32x4, acc[ai][bj][m][n]), 0, 0, 0)); \
          else acc[ai][bj][m][n] = __builtin_amdgcn_mfma_f32_16x16x32_bf16(Bt[n][k], At[m][k], acc[ai][bj][m][n], 0, 0, 0); } __builtin_amdgcn_s_setprio(0); } while (0)
#define PG8_WAIT_V(n) asm volatile("s_waitcnt vmcnt(" #n ")" ::: "memory")
#define PG8_WAIT_L(n) asm volatile("s_waitcnt lgkmcnt(" #n ")" ::: "memory")
#define PG8_BAR __builtin_amdgcn_s_barrier()
#define PG8_SCHED __builtin_amdgcn_sched_barrier(0)
    Unit cur, nxt, prv; int ui = 0;
    if (!S.next(0, cur)) return;
    prv = cur;
    f32x4 acc[2][2][4][2];
#pragma unroll
    for (int a = 0; a < 2; ++a)
#pragma unroll
        for (int b = 0; b < 2; ++b)
#pragma unroll
            for (int m = 0; m < 4; ++m)
#pragma unroll
                for (int n = 0; n < 2; ++n) acc[a][b][m][n] = (f32x4){0.f, 0.f, 0.f, 0.f};
    bf16x8 At[4][2], B0[2][2], B1[2][2];
    unsigned cv[2][2], nv[2][2], aR[2], aC2[2];
    if constexpr (GATHER) {
#pragma unroll
        for (int i = 0; i < 2; ++i) { int R, C; stage_rc(tid * 16 + i * 8192, R, C); aR[i] = (unsigned)R; aC2[i] = (unsigned)C * 2u; }
#pragma unroll
        for (int h = 0; h < 2; ++h)
#pragma unroll
            for (int i = 0; i < 2; ++i) { cv[h][i] = (unsigned)g.sidx[h * HALF + aR[i]] * (unsigned)(K * 2) + aC2[i]; nv[h][i] = cv[h][i]; } }
    const char* cA = (const char*)g.A + (GATHER ? (size_t)0 : (size_t)cur.pm * tstep); const char* cB = (const char*)g.Bt + (size_t)cur.pnb * tstep;
    S.a_ready(cur);
    if constexpr (Epi::PRESCALE) E.prefetch(cur, lds + SCL_OFF, wid, lane);
    if constexpr (SP2) {
        PG8_STAGE(PG8_SB(0, 0), cB, voffB); PG8_STAGE(PG8_SB(0, 1), cB + hstep, voffB); PG8_STAGE_A(PG8_SA(0, 0), cA, 0, false); PG8_STAGE_A(PG8_SA(0, 1), cA, 1, false);
        if (wr == 1) PG8_BAR;
        PG8_WAIT_V(2); PG8_BAR;
        PG8_STAGE(PG8_SB(1, 0), cB + kstep, voffB); PG8_STAGE_A(PG8_SA(1, 0), cA + kstep, 0, false); PG8_STAGE(PG8_SB(1, 1), cB + hstep + kstep, voffB);
        PG8_WAIT_V(6); PG8_BAR;
    } else {
        PG8_STAGE(PG8_SB(0, 0), cB, voffB); PG8_STAGE_A(PG8_SA(0, 0), cA, 0, false); PG8_STAGE(PG8_SB(0, 1), cB + hstep, voffB); PG8_STAGE_A(PG8_SA(0, 1), cA, 1, false);
        if (wr == 1) PG8_BAR;
        PG8_WAIT_V(4); PG8_BAR;
        PG8_STAGE(PG8_SB(1, 0), cB + kstep, voffB); PG8_STAGE_A(PG8_SA(1, 0), cA + kstep, 0, false); PG8_STAGE(PG8_SB(1, 1), cB + hstep + kstep, voffB);
        PG8_WAIT_V(6); PG8_BAR;
    }
    for (;;) {
        const bool has_next = S.next(ui + 1, nxt);
        if constexpr (GATHER) { if (has_next) {
#pragma unroll
            for (int h = 0; h < 2; ++h)
#pragma unroll
                for (int i = 0; i < 2; ++i) nv[h][i] = (unsigned)g.sidx[(ui + 1) * BM + h * HALF + aR[i]] * (unsigned)(K * 2) + aC2[i]; } }
        const bool lastnext_ok = has_next;
        const char* nA = (has_next && !GATHER) ? (const char*)g.A + (size_t)nxt.pm * tstep : cA; const char* nB = has_next ? (const char*)g.Bt + (size_t)nxt.pnb * tstep : cB;
        for (int t = 0; t < nt; t += 2) {
            const bool last = (t == nt - 2); const bool lastnext = last && lastnext_ok;
            const char* a1 = cA + (size_t)(t + 1) * kstep;
            const char* a2 = last ? nA : cA + (size_t)(t + 2) * kstep; const char* b2 = last ? nB : cB + (size_t)(t + 2) * kstep;
            const char* a3 = a2 + kstep; const char* b3 = b2 + kstep;
            if (last && ui > 0) S.done_deferred(prv);
            if (last && has_next) S.a_ready(nxt);
            if constexpr (SP2) {
            PG8_LDB(B0, 0, 0); PG8_LDB(B1, 0, 1); PG8_SCHED; PG8_LDA(At, 0, 0); PG8_STAGE_A(PG8_SA(1, 1), a1, 1, false);
            PG8_WAIT_V(8); PG8_WAIT_L(0); PG8_BAR; PG8_MMA(0, 0, At, B0); PG8_MMA(0, 1, At, B1); PG8_BAR; PG8_SCHED;
            PG8_LDA(At, 0, 1); PG8_STAGE(PG8_SB(0, 0), b2, voffB); PG8_STAGE(PG8_SB(0, 1), b2 + hstep, voffB); PG8_STAGE_A(PG8_SA(0, 0), a2, 0, lastnext);
            PG8_WAIT_V(8); PG8_WAIT_L(0); PG8_BAR; PG8_MMA(1, 0, At, B0); PG8_MMA(1, 1, At, B1); PG8_BAR; PG8_SCHED;
            PG8_LDB(B0, 1, 0); PG8_LDB(B1, 1, 1); PG8_SCHED; PG8_LDA(At, 1, 0); PG8_STAGE_A(PG8_SA(0, 1), a2, 1, lastnext);
            PG8_WAIT_V(8); PG8_WAIT_L(0); PG8_BAR; PG8_MMA(0, 0, At, B0); PG8_MMA(0, 1, At, B1); PG8_BAR; PG8_SCHED;
            PG8_LDA(At, 1, 1); PG8_STAGE(PG8_SB(1, 0), b3, voffB); PG8_STAGE(PG8_SB(1, 1), b3 + hstep, voffB); PG8_STAGE_A(PG8_SA(1, 0), a3, 0, lastnext);
            PG8_WAIT_V(8); PG8_WAIT_L(0); PG8_BAR; PG8_MMA(1, 0, At, B0); PG8_MMA(1, 1, At, B1); PG8_BAR; PG8_SCHED;
            } else {
            PG8_LDB(B0, 0, 0); PG8_SCHED; PG8_LDA(At, 0, 0); PG8_STAGE_A(PG8_SA(1, 1), a1, 1, false);
            PG8_WAIT_L(8); PG8_BAR; PG8_WAIT_L(0); PG8_MMA(0, 0, At, B0); PG8_BAR; PG8_SCHED;
            PG8_LDB(B1, 0, 1); PG8_STAGE(PG8_SB(0, 0), b2, voffB);
            PG8_BAR; PG8_WAIT_L(0); PG8_MMA(0, 1, At, B1); PG8_BAR;
            PG8_LDA(At, 0, 1); PG8_STAGE_A(PG8_SA(0, 0), a2, 0, lastnext);
            PG8_BAR; PG8_WAIT_L(0); PG8_MMA(1, 0, At, B0); PG8_BAR; PG8_SCHED;
            PG8_STAGE(PG8_SB(0, 1), b2 + hstep, voffB);
            PG8_WAIT_V(6); PG8_BAR; PG8_MMA(1, 1, At, B1); PG8_BAR;
            PG8_LDB(B0, 1, 0); PG8_SCHED; PG8_LDA(At, 1, 0); PG8_STAGE_A(PG8_SA(0, 1), a2, 1, lastnext);
            PG8_WAIT_L(8); PG8_BAR; PG8_WAIT_L(0); PG8_MMA(0, 0, At, B0); PG8_BAR; PG8_SCHED;
            PG8_LDB(B1, 1, 1); PG8_STAGE(PG8_SB(1, 0), b3, voffB);
            PG8_BAR; PG8_WAIT_L(0); PG8_MMA(0, 1, At, B1); PG8_BAR;
            PG8_LDA(At, 1, 1); PG8_STAGE_A(PG8_SA(1, 0), a3, 0, lastnext);
            PG8_BAR; PG8_WAIT_L(0); PG8_MMA(1, 0, At, B0); PG8_BAR; PG8_SCHED;
            PG8_STAGE(PG8_SB(1, 1), b3 + hstep, voffB);
            PG8_WAIT_V(6); PG8_BAR; PG8_MMA(1, 1, At, B1); PG8_BAR;
            }
        }
        static_assert(!Epi::SPLIT_BAR || ALIGN_EPI, "SPLIT_BAR epilogues carry the ALIGN_EPI barrier");
        if constexpr (ALIGN_EPI && !Epi::SPLIT_BAR) { if (wr == 0) PG8_BAR; }
        if constexpr (Epi::PRESCALE) { if (has_next) E.prefetch(nxt, lds + SCL_OFF + ((ui + 1) & 1) * SCL_SLOT, wid, lane);
            E(acc, cur, wr, wc, fr, fq, lds + SCL_OFF + (ui & 1) * SCL_SLOT); S.done(cur); }
        else if constexpr (!Epi::AFTER_DRAIN) { E(acc, cur, wr, wc, fr, fq); S.done(cur); }
        if (!has_next) break;
#pragma unroll
        for (int a = 0; a < 2; ++a)
#pragma unroll
            for (int b = 0; b < 2; ++b)
#pragma unroll
                for (int m = 0; m < 4; ++m)
#pragma unroll
                    for (int n = 0; n < 2; ++n) acc[a][b][m][n] = (f32x4){0.f, 0.f, 0.f, 0.f};
        prv = cur; cur = nxt; cA = nA; cB = nB; ++ui;
        if constexpr (GATHER) {
#pragma unroll
            for (int h = 0; h < 2; ++h)
#pragma unroll
                for (int i = 0; i < 2; ++i) cv[h][i] = nv[h][i]; }
        if constexpr (ALIGN_EPI) { if (wr == 1) PG8_BAR; }
    }
    PG8_WAIT_V(0);
    if constexpr (!Epi::AFTER_DRAIN) S.done_deferred(cur);
    if constexpr (!ALIGN_EPI) { if (wr == 0) PG8_BAR; }
    PG8_BAR;
    if constexpr (Epi::AFTER_DRAIN) { E.fused(acc, cur, wr, wc, fr, fq, lds, wid, lane); S.done(cur); }
#undef PG8_SA
#undef PG8_SB
#undef PG8_STAGE
#undef PG8_STAGE_A
#undef PG8_LDA
#undef PG8_LDB
#undef PG8_MMA
#undef PG8_WAIT_V
#undef PG8_WAIT_L
#undef PG8_BAR
#undef PG8_SCHED
}
}

#define XB_TMO      128
#define XB_XCNT(j)  (256  + 64 * (j))
#define XB_XSUB(j)  (1280 + 64 * (j))
#define XB_XGEN(j)  (2304 + 64 * (j))
#define XB_TOP      3328
#define XB_TOPGEN   3392
#define XCD_BAR_WORDS 3456
#define XB_SPIN_CAP (1u << 18)
__device__ __forceinline__ unsigned xb_ld(unsigned* p)              { return __hip_atomic_load(p, __ATOMIC_RELAXED, __HIP_MEMORY_SCOPE_AGENT); }
__device__ __forceinline__ unsigned xb_add(unsigned* p, unsigned v) { return __hip_atomic_fetch_add(p, v, __ATOMIC_RELAXED, __HIP_MEMORY_SCOPE_AGENT); }
__device__ __forceinline__ unsigned xb_xcc_id() { return (unsigned)__builtin_amdgcn_s_getreg((3 << 11) | 20) & 0xFu; }
#define XB_SPIN(cond, bar) do { unsigned _sp = 0; while (cond) { __builtin_amdgcn_s_sleep(1); \
    if ((++_sp & 255u) == 0u) { if (xb_ld(&(bar)[XB_TMO])) break; if (_sp > XB_SPIN_CAP) { atomicAdd(&(bar)[XB_TMO], 1u); break; } } } } while (0)
struct XcdBarrier { unsigned* bar; unsigned x; volatile LAS unsigned* st; };
__device__ __forceinline__ XcdBarrier xcd_barrier_post(unsigned* bar, volatile LAS unsigned* st) {
    XcdBarrier b; b.bar = bar; b.x = xb_xcc_id(); b.st = st;
    if (threadIdx.x == 0) (void)xb_add(&bar[XB_XCNT(b.x)], 1u);
    return b;
}
__device__ __forceinline__ void xcd_barrier_complete(unsigned* bar, unsigned x, unsigned& nloc, unsigned& nx) {
    const unsigned G = gridDim.x * gridDim.y * gridDim.z;
    unsigned sum, cnt, mine, sp = 0u;
    for (;;) {
        sum = 0u; cnt = 0u; mine = 0u;
#pragma unroll
        for (unsigned j = 0; j < 16; ++j) { const unsigned c = xb_ld(&bar[XB_XCNT(j)]); sum += c; cnt += (c > 0u) ? 1u : 0u; mine = (j == x) ? c : mine; }
        if (sum == G) break;
        __builtin_amdgcn_s_sleep(1);
        if ((++sp & 255u) == 0u) { if (xb_ld(&bar[XB_TMO])) break; if (sp > XB_SPIN_CAP) { atomicAdd(&bar[XB_TMO], 1u); break; } }
    }
    nloc = mine > 0u ? mine : 1u; nx = cnt > 0u ? cnt : 1u;
}
__device__ __forceinline__ void xcd_barrier(const XcdBarrier& b) {
    asm volatile("s_waitcnt vmcnt(0)" ::: "memory");
    __syncthreads();
    if (threadIdx.x == 0) {
        unsigned* bar = b.bar;
        __builtin_amdgcn_s_waitcnt(0);
        unsigned nloc = b.st[0], nx = b.st[1];
        if (nloc == 0u) { xcd_barrier_complete(bar, b.x, nloc, nx); b.st[0] = nloc; b.st[1] = nx; }
        const unsigned old = xb_add(&bar[XB_XSUB(b.x)], 1u);
        const unsigned gen = old / nloc;
        if (old + 1u == (gen + 1u) * nloc) {
            __builtin_amdgcn_fence(__ATOMIC_RELEASE, "agent");
            asm volatile("s_waitcnt vmcnt(0)" ::: "memory");
            const unsigned og = xb_add(&bar[XB_TOP], 1u);
            const unsigned tg = og / nx;
            __builtin_amdgcn_fence(__ATOMIC_ACQUIRE, "agent");
            if (og + 1u == (tg + 1u) * nx) xb_add(&bar[XB_TOPGEN], 1u);
            else XB_SPIN(xb_ld(&bar[XB_TOPGEN]) == tg, bar);
            xb_add(&bar[XB_XGEN(b.x)], 1u);
            asm volatile("s_waitcnt vmcnt(0)" ::: "memory");
        } else {
            __builtin_amdgcn_fence(__ATOMIC_ACQUIRE, "agent");
            XB_SPIN(xb_ld(&bar[XB_XGEN(b.x)]) == gen, bar);
            asm volatile("s_waitcnt vmcnt(0)" ::: "memory");
        }
    }
    __syncthreads();
}
constexpr int CW_YA = 8192;
constexpr int CW_BAR = 4096;

struct Args { const float* in[23]; float* out; unsigned char* ws; int ph_lo, ph_hi, li, pad; };
enum { I_X = 0, I_C, I_WADA, I_BADA, I_GPREMIX, I_GPOSTMIX, I_WIN, I_LNVG, I_LNVB, I_WSP, I_BSP, I_LBL, I_GHGRN, I_WOUT, I_GPREFFN, I_GPOSTFFN, I_WRG, I_BRG, I_WRE, I_BRE, I_W1, I_W3, I_W2 };
enum { PH_PREP = 0, PH_HNORM, PH_INPROJ, PH_MIXA, PH_MIXB, PH_OUTPROJ, PH_ROW1, PH_GATHER, PH_MOE1, PH_MOE2, PH_FINAL, PH_N };

struct Frame {
    LAS unsigned char* lds;
    int tid, lane, wave, vcu, G;
};
typedef const __attribute__((address_space(4))) Args KArgs;
__device__ __forceinline__ KArgs* kargs() { KArgs* p = (KArgs*)__builtin_amdgcn_kernarg_segment_ptr(); asm volatile("" : "+s"(p)); return p; }

__host__ __device__ __forceinline__ size_t blk(size_t row, int col) { return ((row >> 4) * 32 + (size_t)(col >> 5)) * 512 + (row & 15) * 32 + (col & 31); }
__host__ __device__ __forceinline__ int inproj_row(int n) {
    const int s = n >> 10, ch = n & 1023, j = ch >> 7, cc = ch & 127;
    const int type = (s == 0 || s == 6) ? 0 : (s == 5 || s == 7) ? 1 : (s == 1 || s == 2) ? 2 : 3;
    const int bj = (s == 0 || s == 5 || s == 1 || s == 3) ? 0 : 1;
    return 256 * (4 * j + type) + 128 * bj + cc;
}

__device__ __forceinline__ void transpose_item(const float* W, int N, int k0, int n0, bf16* WT, int Kd, int r0, LAS float* scr, int lane) {
    const int kr = lane >> 3, nq = lane & 7;
    f32x4 v[8];
#pragma unroll
    for (int i = 0; i < 8; ++i) v[i] = *(const f32x4*)(W + (size_t)(k0 + 8 * i + kr) * N + n0 + 4 * nq);
#pragma unroll
    for (int i = 0; i < 8; ++i) { LAS float* d = scr + (8 * i + kr) * 33 + 4 * nq; d[0] = v[i][0]; d[1] = v[i][1]; d[2] = v[i][2]; d[3] = v[i][3]; }
    LDS_WAIT(); asm volatile("" ::: "memory");
    const int c = lane & 7;
#pragma unroll
    for (int j = 0; j < 4; ++j) { const int n = (lane >> 3) + 8 * j; const LAS float* s = scr + (8 * c) * 33 + n;
        v4u o; o.x = pk2(s[0 * 33], s[1 * 33]); o.y = pk2(s[2 * 33], s[3 * 33]); o.z = pk2(s[4 * 33], s[5 * 33]); o.w = pk2(s[6 * 33], s[7 * 33]);
        *(GAS v4u*)(WT + (size_t)(r0 + n) * Kd + k0 + 8 * c) = o; }
    LDS_WAIT(); asm volatile("" ::: "memory");
}

struct TrDesc { const float* W; bf16* WT; int N, k0, n0, Kd, r0; const float* sc = nullptr; };
template <bool NT> __device__ __forceinline__ f32x4 tr_ld(const f32x4* p) { return NT ? __builtin_nontemporal_load(p) : *p; }
template <bool NT = false> __device__ __forceinline__ void tr_load(f32x4 (&v)[8], const TrDesc& d, int lane) {
    const int kr = lane >> 3, nq = lane & 7;
#pragma unroll
    for (int i = 0; i < 8; ++i) v[i] = tr_ld<NT>((const f32x4*)(d.W + (size_t)(d.k0 + 8 * i + kr) * d.N + d.n0 + 4 * nq));
    asm volatile("" ::: "memory");
}
__device__ __forceinline__ void tr_to_lds(const f32x4 (&v)[8], LAS float* scr, int lane) {
    const int kr = lane >> 3, nq = lane & 7;
#pragma unroll
    for (int i = 0; i < 8; ++i) { LAS float* d = scr + (8 * i + kr) * 33 + 4 * nq; d[0] = v[i][0]; d[1] = v[i][1]; d[2] = v[i][2]; d[3] = v[i][3]; }
    LDS_WAIT(); asm volatile("" ::: "memory");
}
__device__ __forceinline__ unsigned q8pack(float a, float b, float c, float d) {
    const int ia = (int)__builtin_rintf(a), ib = (int)__builtin_rintf(b), ic = (int)__builtin_rintf(c), id = (int)__builtin_rintf(d);
    return (unsigned)(ia & 255) | ((unsigned)(ib & 255) << 8) | ((unsigned)(ic & 255) << 16) | ((unsigned)id << 24);
}
template <bool NT = false> __device__ __forceinline__ void tr_store(const TrDesc& d, LAS float* scr, int lane) {
    const int c = lane & 7;
    if (d.sc) {
#pragma unroll
        for (int j = 0; j < 4; ++j) { const int n = (lane >> 3) + 8 * j; const LAS float* s = scr + (8 * c) * 33 + n; const float inv = 1.0f / d.sc[d.r0 + n];
            v2u o; o.x = q8pack(s[0 * 33] * inv, s[1 * 33] * inv, s[2 * 33] * inv, s[3 * 33] * inv); o.y = q8pack(s[4 * 33] * inv, s[5 * 33] * inv, s[6 * 33] * inv, s[7 * 33] * inv);
            *(GAS v2u*)((signed char*)d.WT + (size_t)(d.r0 + n) * d.Kd + d.k0 + 8 * c) = o; }
        LDS_WAIT(); asm volatile("" ::: "memory"); return; }
#pragma unroll
    for (int j = 0; j < 4; ++j) { const int n = (lane >> 3) + 8 * j; const LAS float* s = scr + (8 * c) * 33 + n;
        v4u o; o.x = pk2(s[0 * 33], s[1 * 33]); o.y = pk2(s[2 * 33], s[3 * 33]); o.z = pk2(s[4 * 33], s[5 * 33]); o.w = pk2(s[6 * 33], s[7 * 33]);
        if (NT) __builtin_nontemporal_store(o, (v4u*)(d.WT + (size_t)(d.r0 + n) * d.Kd + d.k0 + 8 * c)); else *(GAS v4u*)(d.WT + (size_t)(d.r0 + n) * d.Kd + d.k0 + 8 * c) = o; }
    LDS_WAIT(); asm volatile("" ::: "memory");
}
#define TR_PIPELINE(DEC, it0_, stride_, nit_, tv, scr, lane, PRELOADED, NT) do { int it_ = (it0_); if (it_ < (nit_)) { TrDesc d_ = DEC(it_); if (!(PRELOADED)) tr_load<NT>(tv, d_, lane); \
        for (;;) { tr_to_lds(tv, scr, lane); const int nx_ = it_ + (stride_); const bool more_ = nx_ < (nit_); const TrDesc dn_ = DEC(more_ ? nx_ : it_); \
            tr_load<NT>(tv, dn_, lane);                \
            tr_store<NT>(d_, scr, lane); if (!more_) break; d_ = dn_; it_ = nx_; } } } while (0)

__device__ __forceinline__ void strip_quantize(Frame& F, const float* W, int ldW, int n0, signed char* WT8, int r0, float* wsc) {
    LAS float* S = (LAS float*)F.lds;
    LAS float* red = (LAS float*)(F.lds + 139264);
    const int kq = F.tid >> 3, nq = F.tid & 7;
    f32x4 v[16]; f32x4 m = (f32x4){0.f, 0.f, 0.f, 0.f};
#pragma unroll
    for (int i = 0; i < 16; ++i) v[i] = __builtin_nontemporal_load((const f32x4*)(W + (size_t)(kq + 64 * i) * ldW + n0 + 4 * nq));
#pragma unroll
    for (int i = 0; i < 16; ++i) { *(LAS f32x4*)(S + (kq + 64 * i) * 32 + 4 * nq) = v[i];
        m.x = fmaxf(m.x, fabsf(v[i].x)); m.y = fmaxf(m.y, fabsf(v[i].y)); m.z = fmaxf(m.z, fabsf(v[i].z)); m.w = fmaxf(m.w, fabsf(v[i].w)); }
#pragma unroll
    for (int o = 8; o < 64; o <<= 1) { m.x = fmaxf(m.x, __shfl_xor(m.x, o)); m.y = fmaxf(m.y, __shfl_xor(m.y, o)); m.z = fmaxf(m.z, __shfl_xor(m.z, o)); m.w = fmaxf(m.w, __shfl_xor(m.w, o)); }
    if (F.lane < 8) *(LAS f32x4*)(red + F.wave * 32 + 4 * F.lane) = m;
    __syncthreads();
    const int n = F.tid & 31, kg = F.tid >> 5;
    float mx = 0.f;
#pragma unroll
    for (int w = 0; w < NWAVES; ++w) mx = fmaxf(mx, red[w * 32 + n]);
    const float sc = mx > 0.f ? mx * (1.0f / 127.0f) : 1.0f, inv = mx > 0.f ? 127.0f / mx : 0.f;
    if (kg == 0) wsc[r0 + n] = sc;
    signed char* orow = WT8 + (size_t)(r0 + n) * 1024;
#pragma unroll
    for (int j = 0; j < 8; ++j) { const int k0 = 8 * (kg + 16 * j); const LAS float* sp = S + k0 * 32 + n;
        v2u o; o.x = q8pack(sp[0] * inv, sp[32] * inv, sp[64] * inv, sp[96] * inv); o.y = q8pack(sp[128] * inv, sp[160] * inv, sp[192] * inv, sp[224] * inv);
        *(GAS v2u*)(orow + k0) = o; }
    __syncthreads();
}

__device__ __forceinline__ void phase_prep(Frame& F) {
    const KArgs* ap_ = kargs(); const KArgs& a = *ap_; unsigned char* ws = a.ws;
    if (F.vcu == F.G - 1) { const float* lbl = a.in[I_LBL]; float* lbv = (float*)(ws + WS_LBV);
        for (int c = F.tid; c < D; c += NTHREADS) lbv[c] = 1.0f / (1.0f + expf(lbl[D + c] - lbl[c])); }
    LAS float* sc = (LAS float*)F.lds;
    LAS float* red = (LAS float*)(F.lds + 65536);
    bool have_sc = false;
    for (int u = F.vcu; u < 6144 / 32; u += F.G) {
        if (!have_sc) { const float* c = a.in[I_C];
            for (int i = F.tid; i < 16 * D; i += NTHREADS) sc[i] = silu_f(c[i]);
            have_sc = true; __syncthreads(); }
        const int col = F.tid & 31, kq = F.tid >> 5, j0 = 32 * u;
        float acc[16];
#pragma unroll
        for (int b = 0; b < 16; ++b) acc[b] = 0.f;
        const float* w = a.in[I_WADA] + (size_t)(64 * kq) * 6144 + j0 + col;
        float wn[8];
#pragma unroll
        for (int q = 0; q < 8; ++q) wn[q] = w[(size_t)q * 6144];
#pragma unroll
        for (int kk = 0; kk < 64; kk += 8) { float wv[8];
#pragma unroll
            for (int q = 0; q < 8; ++q) wv[q] = wn[q];
            if (kk + 8 < 64) {
#pragma unroll
                for (int q = 0; q < 8; ++q) wn[q] = w[(size_t)(kk + 8 + q) * 6144]; }
#pragma unroll
            for (int b = 0; b < 16; ++b) { const f32x4 s0 = *(const LAS f32x4*)(sc + b * D + 64 * kq + kk), s1 = *(const LAS f32x4*)(sc + b * D + 64 * kq + kk + 4);
                acc[b] += (s0.x * wv[0] + s0.y * wv[1]) + (s0.z * wv[2] + s0.w * wv[3]) + (s1.x * wv[4] + s1.y * wv[5]) + (s1.z * wv[6] + s1.w * wv[7]); } }
#pragma unroll
        for (int b = 0; b < 16; ++b) red[(kq * 16 + b) * 32 + col] = acc[b];
        __syncthreads();
        { const int b = F.tid >> 5; float s = 0.f;
#pragma unroll
          for (int q = 0; q < 16; ++q) s += red[(q * 16 + b) * 32 + col];
          const float v_ = s + a.in[I_BADA][j0 + col];
          if (j0 < 2 * D) __hip_atomic_store((float*)(ws + WS_ADA) + b * 6144 + j0 + col, v_, RLX_AGENT);
          else ((float*)(ws + WS_ADA))[b * 6144 + j0 + col] = v_; }
        if (j0 < 2 * D) { asm volatile("s_waitcnt vmcnt(0)" ::: "memory"); __syncthreads();
            if (F.tid == 0) (void)__hip_atomic_fetch_add((unsigned*)(ws + WS_CTL) + CW_ADA1, 1u, RLX_AGENT); }
        __syncthreads();
    }
}

__device__ __forceinline__ void phase_hnorm(Frame& F, const bool wait_ada) {
    const KArgs* ap_ = kargs(); const KArgs& a = *ap_; unsigned char* ws = a.ws;
    const float* ada = (const float*)(ws + WS_ADA); const float* x = a.in[I_X]; const float* g = a.in[I_GPREMIX]; bf16* H = (bf16*)(ws + WS_H);
    const int rows_per = T / F.G, row0 = (int)blockIdx.x * rows_per;
    constexpr int R = 4; const int step = R * NWAVES, n_it = rows_per / step;
    f32x4 va[R][4], vb[R][4];
#define HN_LOAD(V, i0_) do { _Pragma("unroll") for (int r = 0; r < R; ++r) { const f32x4* xr = (const f32x4*)(x + (size_t)(row0 + (i0_) + r * NWAVES) * D) + F.lane; \
            _Pragma("unroll") for (int j = 0; j < 4; ++j) V[r][j] = __builtin_nontemporal_load(xr + 64 * j); } asm volatile("" ::: "memory"); } while (0)
    HN_LOAD(va, F.wave);
    if (wait_ada) {
        if (F.tid == 0) { unsigned sp_ = 0; while (__hip_atomic_load((unsigned*)(ws + WS_CTL) + CW_ADA1, RLX_AGENT) < (unsigned)(2 * D / 32)) { __builtin_amdgcn_s_sleep(8); if (++sp_ > (1u << 20)) break; }
            __builtin_amdgcn_fence(__ATOMIC_ACQUIRE, "agent"); asm volatile("s_waitcnt vmcnt(0)" ::: "memory"); }
        __syncthreads(); }
    f32x4 gs[4], shv[4];
    { const float* ab = ada + (size_t)(row0 / SEQ) * 6144;
#pragma unroll
      for (int j = 0; j < 4; ++j) { const int c = 256 * j + 4 * F.lane; gs[j] = *(const f32x4*)(g + c) * (*(const f32x4*)(ab + D + c) + 1.0f); shv[j] = *(const f32x4*)(ab + c); } }
#define HN_COMP(V, i0_) do { float s[R], mx[R]; \
        _Pragma("unroll") for (int r = 0; r < R; ++r) { float t = 0.f; \
            _Pragma("unroll") for (int j = 0; j < 4; ++j) t += (V[r][j].x * V[r][j].x + V[r][j].y * V[r][j].y) + (V[r][j].z * V[r][j].z + V[r][j].w * V[r][j].w); \
            s[r] = t; } \
        _Pragma("unroll") for (int o = 1; o < 64; o <<= 1) { _Pragma("unroll") for (int r = 0; r < R; ++r) s[r] += __shfl_xor(s[r], o); } \
        _Pragma("unroll") for (int r = 0; r < R; ++r) { const float rstd = __builtin_amdgcn_rsqf(s[r] * (1.f / D) + RMS_EPS); float t = 0.f; \
            _Pragma("unroll") for (int j = 0; j < 4; ++j) { const f32x4 h = V[r][j] * rstd * gs[j] + shv[j]; V[r][j] = h; \
                t = fmaxf(fmaxf(t, fmaxf(fabsf(h.x), fabsf(h.y))), fmaxf(fabsf(h.z), fabsf(h.w))); } \
            mx[r] = t; } \
        _Pragma("unroll") for (int o = 1; o < 64; o <<= 1) { _Pragma("unroll") for (int r = 0; r < R; ++r) mx[r] = fmaxf(mx[r], __shfl_xor(mx[r], o)); } \
        _Pragma("unroll") for (int r = 0; r < R; ++r) { const int m_ = row0 + (i0_) + r * NWAVES; const float inv = mx[r] > 0.f ? 127.0f / mx[r] : 0.f; \
            unsigned* o4 = (unsigned*)((signed char*)H + (size_t)m_ * D) + F.lane;          \
            _Pragma("unroll") for (int j = 0; j < 4; ++j) o4[64 * j] = q8pack(V[r][j].x * inv, V[r][j].y * inv, V[r][j].z * inv, V[r][j].w * inv); \
            if (F.lane == 0) ((float*)(ws + WS_HSC))[m_] = mx[r] > 0.f ? mx[r] * (1.0f / 127.0f) : 1.0f; } } while (0)
    LAS float* scr = (LAS float*)(F.lds + F.wave * 16384);
    const int gw = F.vcu * NWAVES + F.wave, NGW = F.G * NWAVES;
    constexpr int I_IN = (D / 64) * (NIN / 32), I_OUT = (D / 64) * (D / 32);
    const float* win = a.in[I_WIN]; const float* wout = a.in[I_WOUT];
    auto dec = [&](int it) -> TrDesc { TrDesc d;
        if (it < I_IN) { const int kb = it / (NIN / 32), nb = it % (NIN / 32); d.W = win; d.N = NIN; d.k0 = 64 * kb; d.n0 = 32 * nb; d.WT = (bf16*)(ws + WS_WIN); d.Kd = D; d.r0 = inproj_row(32 * nb); d.sc = (const float*)(ws + WS_WSC); }
        else { const int r = it - I_IN, kb = r / (D / 32), nb = r % (D / 32); d.W = wout; d.N = D; d.k0 = 64 * kb; d.n0 = 32 * nb; d.WT = (bf16*)(ws + WS_WOUT); d.Kd = D; d.r0 = 32 * nb; }
        return d; };
    f32x4 tv[8];
    for (int k = 0; k + 2 < n_it; k += 2) {
        HN_LOAD(vb, F.wave + (k + 1) * step); HN_COMP(va, F.wave + k * step);
        HN_LOAD(va, F.wave + (k + 2) * step); HN_COMP(vb, F.wave + (k + 1) * step); }
    { const int k = n_it - 2;
        HN_LOAD(vb, F.wave + (k + 1) * step); HN_COMP(va, F.wave + k * step);
        { const TrDesc d0 = dec(I_IN + min(gw, I_OUT - 1)); tr_load(tv, d0, F.lane); }
        HN_COMP(vb, F.wave + (k + 1) * step); }
#undef HN_LOAD
#undef HN_COMP
    auto dec_out = [&](int it) -> TrDesc { return dec(I_IN + it); };
    TR_PIPELINE(dec_out, gw, NGW, I_OUT, tv, scr, F.lane, true, false);
    __syncthreads();
    for (int nb = (int)blockIdx.x; nb < NIN / 32; nb += F.G)
        strip_quantize(F, win, NIN, 32 * nb, (signed char*)(ws + WS_WIN), inproj_row(32 * nb), (float*)(ws + WS_WSC));
}

__device__ __forceinline__ float reduce8_transpose(const float (&a)[8], unsigned lane) {
    float b[4], c[2], d;
    { const bool up = (lane & 32) != 0;
#pragma unroll
      for (int k = 0; k < 4; ++k) { const float keep = up ? a[k + 4] : a[k], send = up ? a[k] : a[k + 4]; b[k] = keep + __shfl_xor(send, 32); } }
    { const bool up = (lane & 16) != 0;
#pragma unroll
      for (int k = 0; k < 2; ++k) { const float keep = up ? b[k + 2] : b[k], send = up ? b[k] : b[k + 2]; c[k] = keep + __shfl_xor(send, 16); } }
    { const bool up = (lane & 8) != 0; const float keep = up ? c[1] : c[0], send = up ? c[0] : c[1]; d = keep + __shfl_xor(send, 8); }
    d += __shfl_xor(d, 4); d += __shfl_xor(d, 2); d += __shfl_xor(d, 1);
    return d;
}
__device__ __forceinline__ void phase_row1(Frame& F) {
    const KArgs* ap_ = kargs(); const KArgs& a = *ap_; unsigned char* ws = a.ws;
    const float* ada = (const float*)(ws + WS_ADA); const float* x = a.in[I_X]; const bf16* y2 = (const bf16*)(ws + WS_Y2);
    const float* gpost = a.in[I_GPOSTMIX]; const float* gpre = a.in[I_GPREFFN];
    const float* wrg = a.in[I_WRG]; const float* brg = a.in[I_BRG]; const float* wre = a.in[I_WRE]; const float* bre = a.in[I_BRE];
    bf16* X1B = (bf16*)(ws + WS_X1); bf16* H2 = (bf16*)(ws + WS_H2); int* EID = (int*)(ws + WS_EID); float* EW = (float*)(ws + WS_EW); int* RANK = (int*)(ws + WS_RANK); int* CNT = (int*)(ws + WS_CNT);
    LAS f32x4* s_wre = (LAS f32x4*)F.lds;
    LAS f32x4* s_wrg = (LAS f32x4*)(F.lds + 65536);
    LAS int* s_eid = (LAS int*)(F.lds + 81920);
    LAS float* s_rb = (LAS float*)(F.lds + 83968 + 8 * 256 * 4);
    LAS float* s_h2s = (LAS float*)(F.lds + 93184);
    if (F.tid < 4) s_rb[F.tid] = brg[F.tid]; else if (F.tid < 20) s_rb[F.tid] = bre[F.tid - 4];
#pragma unroll
    for (int k = 0; k < 8; ++k) { const int n = F.tid + NTHREADS * k, ln = n & 63, o4 = (n >> 6) & 3, jq = n >> 8, c = 256 * (jq >> 2) + 4 * ln + (jq & 3);
        s_wre[n] = *(const f32x4*)(wre + (size_t)c * 16 + 4 * o4); }
#pragma unroll
    for (int k = 0; k < 2; ++k) { const int n = F.tid + NTHREADS * k, ln = n & 63, jq = n >> 6, c = 256 * (jq >> 2) + 4 * ln + (jq & 3);
        s_wrg[n] = *(const f32x4*)(wrg + (size_t)c * 4); }
    __syncthreads();
    const int rows_per = T / F.G, row0 = (int)blockIdx.x * rows_per;
    constexpr int R = 2;
    const LAS f32x4* wre_l = s_wre + F.lane; const LAS f32x4* wrg_l = s_wrg + F.lane;
    asm volatile("" : "+v"(wre_l), "+v"(wrg_l));
    f32x4 gtg[4], gs[4], shv[4];
    { const float* ab = ada + (size_t)(row0 / SEQ) * 6144;
#pragma unroll
      for (int j = 0; j < 4; ++j) { const int c = 256 * j + 4 * F.lane;
          gtg[j] = *(const f32x4*)(ab + 2 * D + c) * *(const f32x4*)(gpost + c); gs[j] = *(const f32x4*)(gpre + c) * (*(const f32x4*)(ab + 4 * D + c) + 1.0f); shv[j] = *(const f32x4*)(ab + 3 * D + c); } }
    f32x4 xv[R][4]; v2u yu[R][4];
#define R1_LOAD(i0_) do { _Pragma("unroll") for (int r = 0; r < R; ++r) { const int m = row0 + (i0_) + r * NWAVES; \
            const v2u* yr = (const v2u*)(y2 + (size_t)m * D) + F.lane; const f32x4* xr = (const f32x4*)(x + (size_t)m * D) + F.lane; \
            _Pragma("unroll") for (int j = 0; j < 4; ++j) { yu[r][j] = __builtin_nontemporal_load(yr + 64 * j); xv[r][j] = __builtin_nontemporal_load(xr + 64 * j); } } asm volatile("" ::: "memory"); } while (0)
    R1_LOAD(F.wave);
    for (int i0 = F.wave; i0 < rows_per; i0 += R * NWAVES) {
        f32x4 v[R][4]; float s[R];
#pragma unroll
        for (int r = 0; r < R; ++r) { float t = 0.f;
#pragma unroll
            for (int j = 0; j < 4; ++j) { const v2u yy = yu[r][j]; v[r][j] = (f32x4){bf2f(yy.x & 0xffffu), bf2f(yy.x >> 16), bf2f(yy.y & 0xffffu), bf2f(yy.y >> 16)};
                t += (v[r][j].x * v[r][j].x + v[r][j].y * v[r][j].y) + (v[r][j].z * v[r][j].z + v[r][j].w * v[r][j].w); }
            s[r] = t; }
#pragma unroll
        for (int o = 1; o < 64; o <<= 1) {
#pragma unroll
            for (int r = 0; r < R; ++r) s[r] += __shfl_xor(s[r], o); }
        float s2[R];
#pragma unroll
        for (int r = 0; r < R; ++r) { const int m = row0 + i0 + r * NWAVES;
            const float r1 = __builtin_amdgcn_rsqf(s[r] * (1.f / D) + RMS_EPS); float t = 0.f;
#pragma unroll
            for (int j = 0; j < 4; ++j) {
                v[r][j] = xv[r][j] + gtg[j] * (v[r][j] * r1);
                __builtin_nontemporal_store((unsigned long long)pk2(v[r][j].x, v[r][j].y) | ((unsigned long long)pk2(v[r][j].z, v[r][j].w) << 32), (unsigned long long*)(X1B + (size_t)m * D) + F.lane + 64 * j);
                t += (v[r][j].x * v[r][j].x + v[r][j].y * v[r][j].y) + (v[r][j].z * v[r][j].z + v[r][j].w * v[r][j].w); }
            s2[r] = t; }
        R1_LOAD((i0 + R * NWAVES < rows_per) ? i0 + R * NWAVES : i0);
#pragma unroll
        for (int o = 1; o < 64; o <<= 1) {
#pragma unroll
            for (int r = 0; r < R; ++r) s2[r] += __shfl_xor(s2[r], o); }
        float hmx[R];
#pragma unroll
        for (int r = 0; r < R; ++r) {
            const float r2 = __builtin_amdgcn_rsqf(s2[r] * (1.f / D) + RMS_EPS);
            float t = 0.f;
#pragma unroll
            for (int j = 0; j < 4; ++j) {
                const f32x4 h = v[r][j] * r2 * gs[j] + shv[j]; v[r][j] = h;
                t = fmaxf(fmaxf(t, fmaxf(fabsf(h.x), fabsf(h.y))), fmaxf(fabsf(h.z), fabsf(h.w))); }
            hmx[r] = t; }
#pragma unroll
        for (int o = 1; o < 64; o <<= 1) {
#pragma unroll
            for (int r = 0; r < R; ++r) hmx[r] = fmaxf(hmx[r], __shfl_xor(hmx[r], o)); }
#pragma unroll
        for (int r = 0; r < R; ++r) { const int m = row0 + i0 + r * NWAVES; const float inv = hmx[r] > 0.f ? 127.0f / hmx[r] : 0.f;
            unsigned* o4 = (unsigned*)((signed char*)H2 + (size_t)m * D) + F.lane;
#pragma unroll
            for (int j = 0; j < 4; ++j) o4[64 * j] = q8pack(v[r][j].x * inv, v[r][j].y * inv, v[r][j].z * inv, v[r][j].w * inv);
            if (F.lane == 0) s_h2s[i0 + r * NWAVES] = hmx[r] > 0.f ? hmx[r] * (1.0f / 127.0f) : 1.0f; }
        LAS float* s_lg = (LAS float*)(F.lds + 83968 + F.wave * 256);
        float pa[4 * R];
#pragma unroll
        for (int k = 0; k < 4 * R; ++k) pa[k] = 0.f;
#pragma unroll
        for (int j = 0; j < 4; ++j) {
#pragma unroll
            for (int q = 0; q < 4; ++q) { const f32x4 wg = wrg_l[(4 * j + q) * 64];
#pragma unroll
                for (int r = 0; r < R; ++r) { const float hv = v[r][j][q]; pa[4 * r] += hv * wg.x; pa[4 * r + 1] += hv * wg.y; pa[4 * r + 2] += hv * wg.z; pa[4 * r + 3] += hv * wg.w; } }
            asm volatile("" ::: "memory"); }
        s_lg[(F.lane >> 3) & 7] = reduce8_transpose(pa, F.lane);
        int gi_[R]; float ptop_[R];
#pragma unroll
        for (int r = 0; r < R; ++r) { const f32x4 glv = *(const LAS f32x4*)(s_lg + 4 * r);
            float gl[4] = {glv.x + s_rb[0], glv.y + s_rb[1], glv.z + s_rb[2], glv.w + s_rb[3]}; int gi = 0;
            float gm = gl[0];
#pragma unroll
            for (int q = 1; q < 4; ++q) if (gl[q] > gm) { gm = gl[q]; gi = q; }
            float gsum = 0.f;
#pragma unroll
            for (int q = 0; q < 4; ++q) gsum += __expf(gl[q] - gm);
            gi_[r] = gi; ptop_[r] = __builtin_amdgcn_rcpf(gsum); }
#pragma unroll
        for (int k = 0; k < 4 * R; ++k) pa[k] = 0.f;
#pragma unroll
        for (int r = 0; r < R; ++r) { const LAS f32x4* wr = wre_l + gi_[r] * 64;
#pragma unroll
            for (int j = 0; j < 4; ++j) {
#pragma unroll
                for (int q = 0; q < 4; ++q) { const f32x4 we = wr[(4 * j + q) * 256]; const float hv = v[r][j][q];
                    pa[4 * r] += hv * we.x; pa[4 * r + 1] += hv * we.y; pa[4 * r + 2] += hv * we.z; pa[4 * r + 3] += hv * we.w; }
                asm volatile("" ::: "memory"); } }
        s_lg[8 + ((F.lane >> 3) & 7)] = reduce8_transpose(pa, F.lane);
#pragma unroll
        for (int r = 0; r < R; ++r) { const int i = i0 + r * NWAVES, m = row0 + i;
            const int gi = gi_[r]; const float ptop = ptop_[r];
            const f32x4 elv = *(const LAS f32x4*)(s_lg + 8 + 4 * r), brv = *(const LAS f32x4*)(s_rb + 4 + 4 * gi);
            float el[4]; el[0] = elv.x + brv.x; el[1] = elv.y + brv.y; el[2] = elv.z + brv.z; el[3] = elv.w + brv.w;
            int i0e = 0; float m0 = el[0];
#pragma unroll
            for (int q = 1; q < 4; ++q) if (el[q] > m0) { m0 = el[q]; i0e = q; }
            int i1 = -1; float m1 = -INFINITY;
#pragma unroll
            for (int q = 0; q < 4; ++q) if (q != i0e && el[q] > m1) { m1 = el[q]; i1 = q; }
            if (i1 < 0) { i1 = (i0e + 1) & 3; m1 = m0; }
            const float e1 = __expf(m1 - m0), w0 = ptop * __builtin_amdgcn_rcpf(1.0f + e1), w1 = w0 * e1;
            if (F.lane == 0) { EID[2 * m] = 4 * gi + i0e; EID[2 * m + 1] = 4 * gi + i1; EW[2 * m] = w0; EW[2 * m + 1] = w1; s_eid[2 * i] = 4 * gi + i0e; s_eid[2 * i + 1] = 4 * gi + i1; }
        }
    }
#undef R1_LOAD
    __syncthreads();
    LAS int* s_wc = (LAS int*)(F.lds + 83968 + 8192 + 128);
    int my_e = -1, my_rank = 0;
    if ((int)F.tid < 2 * rows_per) { my_e = s_eid[F.tid];
#pragma unroll
        for (int ee = 0; ee < NE; ++ee) { const unsigned long long mk = __ballot(my_e == ee);
            if (my_e == ee) my_rank = (int)__builtin_amdgcn_mbcnt_hi((unsigned)(mk >> 32), __builtin_amdgcn_mbcnt_lo((unsigned)mk, 0u));
            if ((int)F.lane == ee) s_wc[F.wave * NE + ee] = __popcll(mk); } }
    else if (F.lane < NE) s_wc[F.wave * NE + F.lane] = 0;
    __syncthreads();
    LAS int* s_gb = s_wc + NWAVES * NE;
    if (F.tid < NE) { int c = 0;
#pragma unroll
        for (int w = 0; w < NWAVES; ++w) c += s_wc[w * NE + F.tid];
        s_gb[F.tid] = (int)__hip_atomic_fetch_add((unsigned*)(ws + WS_CTL) + CW_TOT + 64 * F.tid, (unsigned)c, __ATOMIC_RELAXED, __HIP_MEMORY_SCOPE_AGENT); }
    __syncthreads();
    if ((int)F.tid < 2 * rows_per) { int base = s_gb[my_e];
        for (int w = 0; w < F.wave; ++w) base += s_wc[w * NE + my_e];
        const int lr = base + my_rank;
        RANK[2 * row0 + F.tid] = lr; ((int*)(ws + WS_IDXREL))[my_e * 65536 + lr] = row0 + ((int)F.tid >> 1); ((float*)(ws + WS_SCREL))[my_e * 65536 + lr] = s_h2s[F.tid >> 1]; }
    __syncthreads();
}

typedef short v4i16 __attribute__((ext_vector_type(4)));
__device__ __forceinline__ unsigned offb(unsigned row, unsigned ch) { return 256u * row + 16u * (ch ^ (((row & 3u) << 2) | ((row >> 2) & 3u))); }
__device__ __forceinline__ unsigned rra16(unsigned lane, unsigned rb, unsigned s) { return offb((lane & 15u) + 16u * rb, 4u * s + (lane >> 4)); }
__device__ __forceinline__ unsigned tra16(unsigned lane, unsigned c, unsigned ks, unsigned t) { const unsigned g = lane >> 4, q = (lane & 15u) >> 2, p = lane & 3u; return offb(32u * ks + 8u * g + 4u * t + q, 2u * c + (p >> 1)) + 8u * (p & 1u); }
__device__ __forceinline__ bf16x8 ldrow(LAS unsigned char* img, unsigned off) { return *(const LAS bf16x8*)(img + off); }
__device__ __forceinline__ bf16x8 ldtr(LAS unsigned char* img, unsigned off0, unsigned off1) {
    const v4i16 x = __builtin_amdgcn_ds_read_tr16_b64_v4i16((LAS v4i16*)(img + off0)), y = __builtin_amdgcn_ds_read_tr16_b64_v4i16((LAS v4i16*)(img + off1));
    return (bf16x8){x[0], x[1], x[2], x[3], y[0], y[1], y[2], y[3]};
}
typedef __bf16 bf16x2_t __attribute__((ext_vector_type(2)));
__device__ __forceinline__ unsigned cvtpk(float lo, float hi) { const f32x2 v = {lo, hi}; const bf16x2_t b = __builtin_convertvector(v, bf16x2_t); return __builtin_bit_cast(unsigned, b); }
__device__ __forceinline__ float bflo(unsigned u) { return __builtin_bit_cast(float, u << 16); }
__device__ __forceinline__ float bfhi(unsigned u) { return __builtin_bit_cast(float, u & 0xffff0000u); }
__device__ __forceinline__ unsigned spoff(unsigned v, unsigned ch) { return 256u * v + 16u * (ch ^ v); }
__device__ __forceinline__ unsigned poff(unsigned t, unsigned ch) { return 128u * t + 16u * (ch ^ (t & 7u)); }
__device__ __forceinline__ unsigned zvoff(unsigned t, unsigned ch) { return 256u * t + 16u * (ch ^ (t & 15u)); }
constexpr int MA_WC = 0, MA_VN = 32768, MA_ZV = 65536, MA_MU = 98304, MA_RS = 98816, MA_CST = 99328;
__device__ __forceinline__ void mixa_units(Frame& F, const int gg, const int u0, const int du, const int nu, unsigned* flag) {
    const KArgs* ap_ = kargs(); const KArgs& a = *ap_; unsigned char* ws = a.ws;
    const bf16 *GAU = (const bf16*)(ws + WS_GAU), *GV = (const bf16*)(ws + WS_GV); const float* VSTAT = (const float*)(ws + WS_VSTAT); bf16* Y = (bf16*)(ws + WS_H);
    const int tid = F.tid, w = F.wave, crow = tid >> 4, cch = tid & 15;
    const __amdgpu_buffer_rsrc_t yrs = __builtin_amdgcn_make_buffer_rsrc(Y, 0, T * D * 2, 0x00020000);
    LAS unsigned char* const WC = F.lds + MA_WC; LAS unsigned char* const VN = F.lds + MA_VN; LAS unsigned char* const ZV = F.lds + MA_ZV;
    LAS float* const s_mu = (LAS float*)(F.lds + MA_MU); LAS float* const s_rs = (LAS float*)(F.lds + MA_RS);
    LAS float* const s_lng = (LAS float*)(F.lds + MA_CST); LAS float* const s_lnb = s_lng + 128; LAS float* const s_bsp = s_lng + 256;
    { const float* W = a.in[I_WSP] + (size_t)gg * 16384;
#pragma unroll
      for (int k = 0; k < 4; ++k) { const int row = crow + 32 * k; const f32x4 w0 = *(const f32x4*)(W + row * 128 + 8 * cch), w1 = *(const f32x4*)(W + row * 128 + 8 * cch + 4);
          float v[8] = {w0[0], w0[1], w0[2], w0[3], w1[0], w1[1], w1[2], w1[3]};
#pragma unroll
          for (int i = 0; i < 8; ++i) v[i] = (8 * cch + i <= row) ? v[i] : 0.f;
          v4u o; o.x = cvtpk(v[0], v[1]); o.y = cvtpk(v[2], v[3]); o.z = cvtpk(v[4], v[5]); o.w = cvtpk(v[6], v[7]);
          *(LAS v4u*)(WC + offb(row, cch)) = o; } }
    if (tid < 128) { s_lng[tid] = a.in[I_LNVG][128 * gg + tid]; s_lnb[tid] = a.in[I_LNVB][128 * gg + tid]; s_bsp[tid] = a.in[I_BSP][128 * gg + tid]; }
    for (int ui = 0; ui < nu; ++ui) { const int u = u0 + ui * du;
        const size_t t0 = (size_t)(u >> 4) * SEQ + 128 * (u & 15);
        unsigned lane = F.lane; asm volatile("" : "+v"(lane));
        const unsigned g = lane >> 4, l15 = lane & 15;
        v4u gvr[4], gar[4];
#pragma unroll
        for (int k = 0; k < 4; ++k) { const size_t off = blk(t0 + crow + 32 * k, 128 * gg + 8 * cch); gvr[k] = __builtin_nontemporal_load((const v4u*)(GV + off)); gar[k] = __builtin_nontemporal_load((const v4u*)(GAU + off)); }
        float mu_ = 0.f, rs_ = 0.f;
        if (tid < 128) { const f32x4* p = (const f32x4*)(VSTAT + (t0 + tid) * 64); float s = 0.f, ss = 0.f;
#pragma unroll
            for (int q = 0; q < 16; ++q) { const f32x4 v = p[q]; s += v[0] + v[2]; ss += v[1] + v[3]; }
            mu_ = s * (1.f / D); rs_ = __builtin_amdgcn_rsqf(ss * (1.f / D) - mu_ * mu_ + LN_EPS); }
        __syncthreads();
        if (tid < 128) { s_mu[tid] = mu_; s_rs[tid] = rs_; }
        __syncthreads();
        { float lng[8], lnb[8];
          { const f32x4 a0 = *(const LAS f32x4*)(s_lng + 8 * cch), a1 = *(const LAS f32x4*)(s_lng + 8 * cch + 4), b0 = *(const LAS f32x4*)(s_lnb + 8 * cch), b1 = *(const LAS f32x4*)(s_lnb + 8 * cch + 4);
#pragma unroll
            for (int i = 0; i < 4; ++i) { lng[i] = a0[i]; lng[4 + i] = a1[i]; lnb[i] = b0[i]; lnb[4 + i] = b1[i]; } }
#pragma unroll
          for (int k = 0; k < 4; ++k) { const int row = crow + 32 * k; const float mu = s_mu[row], rs = s_rs[row]; const v4u x = gvr[k]; v4u o;
              o.x = cvtpk((bflo(x.x) - mu) * rs * lng[0] + lnb[0], (bfhi(x.x) - mu) * rs * lng[1] + lnb[1]); o.y = cvtpk((bflo(x.y) - mu) * rs * lng[2] + lnb[2], (bfhi(x.y) - mu) * rs * lng[3] + lnb[3]);
              o.z = cvtpk((bflo(x.z) - mu) * rs * lng[4] + lnb[4], (bfhi(x.z) - mu) * rs * lng[5] + lnb[5]); o.w = cvtpk((bflo(x.w) - mu) * rs * lng[6] + lnb[6], (bfhi(x.w) - mu) * rs * lng[7] + lnb[7]);
              *(LAS v4u*)(VN + offb(row, cch)) = o; } }
        __syncthreads();
        { bf16x8 va[4];
#pragma unroll
          for (int ks = 0; ks < 4; ++ks) va[ks] = ldtr(VN, tra16(lane, w, ks, 0), tra16(lane, w, ks, 1));
#pragma unroll
          for (int nt = 0; nt < 8; ++nt) { const float bs = s_bsp[16 * nt + l15]; f32x4 acc = (f32x4){bs, bs, bs, bs};
#pragma unroll
              for (int ks = 0; ks < 4; ++ks) if (ks <= nt / 2) acc = __builtin_amdgcn_mfma_f32_16x16x32_bf16(va[ks], ldrow(WC, rra16(lane, nt, ks)), acc, 0, 0, 0);
              *(LAS v2u*)(ZV + zvoff(16 * nt + l15, 2 * w + (g >> 1)) + 8 * (g & 1)) = (v2u){cvtpk(acc[0], acc[1]), cvtpk(acc[2], acc[3])}; } }
        __syncthreads();
#pragma unroll
        for (int k = 0; k < 4; ++k) { const int row = crow + 32 * k; const v4u z = *(const LAS v4u*)(ZV + zvoff(row, cch)), ga = gar[k]; v4u o;
            o.x = cvtpk(bflo(ga.x) * bflo(z.x), bfhi(ga.x) * bfhi(z.x)); o.y = cvtpk(bflo(ga.y) * bflo(z.y), bfhi(ga.y) * bfhi(z.y));
            o.z = cvtpk(bflo(ga.z) * bflo(z.z), bfhi(ga.z) * bfhi(z.z)); o.w = cvtpk(bflo(ga.w) * bflo(z.w), bfhi(ga.w) * bfhi(z.w));
            if (flag) __builtin_amdgcn_raw_buffer_store_b128(o, yrs, (unsigned)(((t0 + row) * D + 128 * gg + 8 * cch) * 2), 0,   16);
            else *(v4u*)(Y + (t0 + row) * D + 128 * gg + 8 * cch) = o; }
        if (flag) { asm volatile("s_waitcnt vmcnt(0)" ::: "memory");
            __syncthreads();
            if (tid == 0) __hip_atomic_store(flag, (unsigned)(ui + 1), RLX_AGENT); }
    }
}
__device__ __forceinline__ void phase_mixa(Frame& F) { mixa_units(F, (int)blockIdx.x & 7, (int)blockIdx.x >> 3, F.G >> 3, (BATCH * (SEQ / 128)) / (F.G >> 3), nullptr); }

constexpr int MC_SP = 0, MC_IV = 32768, MC_QT = 49152, MC_KT = 81920, MC_O = 114688, MC_P = 132096, MC_D = 140288, MC_SQ = 141312, MC_GH = 142336;
__device__ __forceinline__ void moe_weight_copies(Frame& F, int k, int nb) {
    const KArgs* ap_ = kargs(); const KArgs& a = *ap_; unsigned char* ws = a.ws;
    const float* w1 = a.in[I_W1]; const float* w3 = a.in[I_W3]; const float* w2 = a.in[I_W2];
    for (int st = k; st < NE * 2 * (FF / 32); st += nb) { const int e = st / (2 * (FF / 32)), rem = st % (2 * (FF / 32)), bj = rem / (FF / 32), n0 = 32 * (rem % (FF / 32));
        strip_quantize(F, (bj ? w3 : w1) + (size_t)e * D * FF, FF, n0, (signed char*)(ws + WS_W13) + (size_t)e * D * D, 256 * (n0 >> 7) + 128 * bj + (n0 & 127), (float*)(ws + WS_WSC13) + e * D); }
    LAS float* scr = (LAS float*)(F.lds + F.wave * 16384);
    constexpr int I2 = (FF / 64) * (D / 32);
    auto dec = [&](int it) -> TrDesc { TrDesc d; const int e = it / I2, r = it % I2, kb = r / (D / 32), nbk = r % (D / 32);
        d.W = w2 + (size_t)e * FF * D; d.N = D; d.k0 = 64 * kb; d.n0 = 32 * nbk; d.WT = (bf16*)(ws + WS_W2) + (size_t)e * D * FF; d.Kd = FF; d.r0 = 32 * nbk; return d; };
    f32x4 tv[8];
    TR_PIPELINE(dec, k * NWAVES + F.wave, nb * NWAVES, NE * I2, tv, scr, F.lane, false, true);
}
__device__ __forceinline__ void phase_mixb(Frame& F) {
    if ((int)blockIdx.x >= BATCH * 8) { const int nb = F.G - BATCH * 8, k = (int)blockIdx.x - BATCH * 8;
        const KArgs* ap0_ = kargs(); unsigned* const flag_ = (unsigned*)(ap0_->ws + WS_CTL) + CW_YA + 64 * k;
        if (k < BATCH * 8) mixa_units(F, k & 7, 16 * (k >> 3), 1, SEQ / 128, flag_);
        __syncthreads();
        moe_weight_copies(F, k, nb); return; }
    const KArgs* ap_ = kargs(); const KArgs& a = *ap_; unsigned char* ws = a.ws;
    const bf16 *GBOG = (const bf16*)(ws + WS_GBOG), *QS = (const bf16*)(ws + WS_QS), *G = (const bf16*)(ws + WS_G), *IV = (const bf16*)(ws + WS_IV); bf16* Y = (bf16*)(ws + WS_H);
    const int b = (int)blockIdx.x >> 3, h = (int)blockIdx.x & 7, w = F.wave;
    const unsigned lane = F.lane, g = lane >> 4, l15 = lane & 15;
    const bool is_state = w < 4;
    LAS float* const s_d = (LAS float*)(F.lds + MC_D); LAS float* const s_sq = (LAS float*)(F.lds + MC_SQ); LAS float* const s_ghg = (LAS float*)(F.lds + MC_GH);
    LAS unsigned char* const IVI = F.lds + MC_IV; LAS unsigned char* const PB = F.lds + MC_P; LAS unsigned char* const OB = F.lds + MC_O;
    if (F.tid < 128) s_ghg[F.tid] = a.in[I_GHGRN][128 * h + F.tid];
    const size_t tb = (size_t)b * SEQ;
    constexpr int NC = SEQ / 64;
    unsigned* const yaflag = (unsigned*)(ws + WS_CTL) + CW_YA + 64 * (int)blockIdx.x;
    unsigned ya_seen = 0;
#define YA_ENSURE(cs_) do { const unsigned need_ = (unsigned)((cs_) >> 1) + 1u; if (w == 0 && ya_seen < need_) { unsigned v_ = 0; \
        if (lane == 0) { unsigned sp_ = 0; do { v_ = __hip_atomic_load(yaflag, RLX_AGENT); if (v_ >= need_) break; __builtin_amdgcn_s_sleep(8); } while (++sp_ < (1u << 15)); } \
        ya_seen = (unsigned)__builtin_amdgcn_readfirstlane((int)v_); __builtin_amdgcn_fence(__ATOMIC_ACQUIRE, "agent"); asm volatile("s_waitcnt vmcnt(0)" ::: "memory"); } } while (0)
    unsigned ya_v = 0; bool ya_pend = false;
#define YA_ISSUE(cs_) do { const unsigned need_ = (unsigned)((cs_) >> 1) + 1u; ya_pend = (w == 0 && ya_seen < need_); if (ya_pend) ya_v = __hip_atomic_load(yaflag, RLX_AGENT); asm volatile("" ::: "memory"); } while (0)
#define YA_FINISH(cs_) do { if (ya_pend) { const unsigned need_ = (unsigned)((cs_) >> 1) + 1u; unsigned v_ = (unsigned)__builtin_amdgcn_readfirstlane((int)ya_v); \
        if (v_ < need_) { unsigned t_ = v_; if (lane == 0) { unsigned sp_ = 0; do { t_ = __hip_atomic_load(yaflag, RLX_AGENT); if (t_ >= need_) break; __builtin_amdgcn_s_sleep(8); } while (++sp_ < (1u << 15)); } v_ = (unsigned)__builtin_amdgcn_readfirstlane((int)t_); } \
        ya_seen = v_; __builtin_amdgcn_fence(__ATOMIC_ACQUIRE, "agent"); asm volatile("s_waitcnt vmcnt(0)" ::: "memory"); } } while (0)
#define SC_SCORES(pp, q) do { LAS unsigned char* const QT_ = F.lds + MC_QT + (pp) * 16384; LAS unsigned char* const KT_ = F.lds + MC_KT + (pp) * 16384; \
        bf16x8 kf[4]; _Pragma("unroll") for (int ks = 0; ks < 4; ++ks) kf[ks] = ldrow(KT_, rra16(lane, q, ks)); \
        _Pragma("unroll") for (int nt = 0; nt < 4; ++nt) { f32x4 acc = (f32x4){0.f, 0.f, 0.f, 0.f}; \
            if (nt >= q) { bf16x8 qf[4]; _Pragma("unroll") for (int ks = 0; ks < 4; ++ks) qf[ks] = ldrow(QT_, rra16(lane, nt, ks)); \
                _Pragma("unroll") for (int ks = 0; ks < 4; ++ks) acc = __builtin_amdgcn_mfma_f32_16x16x32_bf16(kf[ks], qf[ks], acc, 0, 0, 0); } \
            const int t = 16 * nt + l15, s0 = 16 * q + 4 * g; \
            const float p0 = (s0 + 0 <= t) ? acc[0] : 0.f, p1 = (s0 + 1 <= t) ? acc[1] : 0.f, p2 = (s0 + 2 <= t) ? acc[2] : 0.f, p3 = (s0 + 3 <= t) ? acc[3] : 0.f; \
            *(LAS v2u*)(PB + poff(t, 2 * q + (g >> 1)) + 8 * (g & 1)) = (v2u){cvtpk(p0, p1), cvtpk(p2, p3)}; } } while (0)
    if (!is_state) {
        const int q = w & 3; const unsigned kp = 16 * q + l15, tq = g, st = 64 * q + lane, mrow = st >> 2, mch = 4 * (st & 3);
        const unsigned lGb = 2u * ((((unsigned)tq * 32u + (kp >> 4)) << 9) + 2u * (kp & 15u));
        const unsigned lIb = 2u * (((((unsigned)mrow >> 4) * 32u + (st & 3u)) << 9) + ((unsigned)mrow & 15u) * 32u);
        const unsigned lYb = 2u * ((unsigned)mrow * (unsigned)D + 8u * (unsigned)mch);
#define CH_BLK(p_, cs_) ((const char*)(p_) + 2 * ((((tb >> 4) + 4 * (size_t)(cs_)) * 32 + 4 * (size_t)h) << 9))
#define CH_ROW(p_, cs_) ((const char*)(p_) + 2 * ((tb + 64 * (size_t)(cs_)) * D + 128 * (size_t)h))
        unsigned UA[48], UB[48], V[32];
#define SC_LOAD(U, cs_) do { const char* const gG_ = CH_BLK(G, cs_) + lGb; const char* const gQ_ = CH_BLK(QS, cs_) + lGb; const char* const gI_ = CH_BLK(IV, cs_) + lIb; \
        _Pragma("unroll") for (int i = 0; i < 16; ++i) { U[i] = *(const unsigned*)(gG_ + 64 * i); U[16 + i] = *(const unsigned*)(gQ_ + 64 * i); } \
        _Pragma("unroll") for (int k = 0; k < 4; ++k) { const v4u t_ = *(const v4u*)(gI_ + 16 * k); U[32 + 4 * k] = t_.x; U[33 + 4 * k] = t_.y; U[34 + 4 * k] = t_.z; U[35 + 4 * k] = t_.w; } \
        asm volatile("" ::: "memory"); } while (0)
#define MG_LOAD(cs_) do { const char* const gY_ = CH_ROW(Y, cs_) + lYb; const char* const gB_ = CH_BLK(GBOG, cs_) + lIb; \
        _Pragma("unroll") for (int k = 0; k < 4; ++k) { const v4u ya_ = *(const v4u*)(gY_ + 16 * k), gb_ = *(const v4u*)(gB_ + 16 * k); \
            V[4 * k] = ya_.x; V[4 * k + 1] = ya_.y; V[4 * k + 2] = ya_.z; V[4 * k + 3] = ya_.w; V[16 + 4 * k] = gb_.x; V[17 + 4 * k] = gb_.y; V[18 + 4 * k] = gb_.z; V[19 + 4 * k] = gb_.w; } \
        asm volatile("" ::: "memory"); } while (0)
#define SC_IVIMG(U) do { _Pragma("unroll") for (int k = 0; k < 4; ++k) *(LAS v4u*)(IVI + offb(mrow, mch + k)) = (v4u){U[32 + 4 * k], U[33 + 4 * k], U[34 + 4 * k], U[35 + 4 * k]}; } while (0)
#define SC_SCAN(U, pp) do { float s0_ = 0.f, s1_ = 0.f; _Pragma("unroll") for (int i = 0; i < 16; ++i) { s0_ += bflo(U[i]); s1_ += bfhi(U[i]); } \
        float r0 = 0.f, r1 = 0.f; _Pragma("unroll") for (int j = 1; j < 4; ++j) { const float a0 = __shfl(s0_, (int)(l15 + 16 * j)), a1 = __shfl(s1_, (int)(l15 + 16 * j)); r0 += ((unsigned)j > tq) ? a0 : 0.f; r1 += ((unsigned)j > tq) ? a1 : 0.f; } \
        float E0 = pg8::ex2(r0 * pg8::L2E), E1 = pg8::ex2(r1 * pg8::L2E); unsigned kq_ = kp; asm volatile("" : "+v"(kq_)); const unsigned ab_ = (pp) * 16384 + 4 * (kq_ & 3), kc_ = kq_ >> 2; \
        _Pragma("unroll") for (int i = 15; i >= 0; --i) { const unsigned t = 16 * tq + i; r0 += bflo(U[i]); r1 += bfhi(U[i]); const float n0 = pg8::ex2(r0 * pg8::L2E), n1 = pg8::ex2(r1 * pg8::L2E); \
            const unsigned ad = ab_ + offb(t, kc_); \
            *(LAS unsigned*)(F.lds + MC_QT + ad) = cvtpk(bflo(U[16 + i]) * pg8::rcp(E0), bfhi(U[16 + i]) * pg8::rcp(E1)); *(LAS unsigned*)(F.lds + MC_KT + ad) = cvtpk(E0 - n0, E1 - n1); E0 = n0; E1 = n1; } \
        if (tq == 0) *(LAS f32x2*)(s_d + (pp) * 128 + 2 * kp) = (f32x2){E0, E1}; } while (0)
#define SC_MERGE(c_) do { char* const sY_ = (char*)CH_ROW(Y, c_) + lYb; const f32x4 sq_ = *(const LAS f32x4*)(s_sq + 4 * mrow); \
        const float rstd = __builtin_amdgcn_rsqf(((sq_[0] + sq_[1]) + (sq_[2] + sq_[3])) * (1.f / 128.f) + RMS_EPS); \
        _Pragma("unroll") for (int k = 0; k < 4; ++k) { const v4u o_ = *(const LAS v4u*)(OB + zvoff(mrow, mch + k)); const f32x4 g0 = *(const LAS f32x4*)(s_ghg + 8 * (mch + k)), g1 = *(const LAS f32x4*)(s_ghg + 8 * (mch + k) + 4); v4u y_; \
            y_.x = cvtpk(bflo(V[4 * k]) + bflo(V[16 + 4 * k]) * (bflo(o_.x) * rstd * g0[0]), bfhi(V[4 * k]) + bfhi(V[16 + 4 * k]) * (bfhi(o_.x) * rstd * g0[1])); \
            y_.y = cvtpk(bflo(V[4 * k + 1]) + bflo(V[17 + 4 * k]) * (bflo(o_.y) * rstd * g0[2]), bfhi(V[4 * k + 1]) + bfhi(V[17 + 4 * k]) * (bfhi(o_.y) * rstd * g0[3])); \
            y_.z = cvtpk(bflo(V[4 * k + 2]) + bflo(V[18 + 4 * k]) * (bflo(o_.z) * rstd * g1[0]), bfhi(V[4 * k + 2]) + bfhi(V[18 + 4 * k]) * (bfhi(o_.z) * rstd * g1[1])); \
            y_.w = cvtpk(bflo(V[4 * k + 3]) + bflo(V[19 + 4 * k]) * (bflo(o_.w) * rstd * g1[2]), bfhi(V[4 * k + 3]) + bfhi(V[19 + 4 * k]) * (bfhi(o_.w) * rstd * g1[3])); \
            *(v4u*)(sY_ + 16 * k) = y_; } } while (0)
        SC_LOAD(UA, 0); SC_LOAD(UB, 1); SC_SCAN(UA, 0);
        __syncthreads();
        MG_LOAD(0); SC_IVIMG(UA); SC_LOAD(UA, 2);
        __syncthreads();
        for (int c = 0; c < NC; c += 2) {
            SC_SCAN(UB, 1);
            __syncthreads();
            SC_MERGE(c); MG_LOAD(c + 1); SC_IVIMG(UB); SC_LOAD(UB, min(c + 3, NC - 1));
            __syncthreads();
            SC_SCAN(UA, 0);
            __syncthreads();
            SC_MERGE(c + 1); MG_LOAD(min(c + 2, NC - 1)); SC_IVIMG(UA); SC_LOAD(UA, min(c + 4, NC - 1));
            __syncthreads();
        }
#undef CH_BLK
#undef CH_ROW
#undef SC_LOAD
#undef MG_LOAD
#undef SC_IVIMG
#undef SC_SCAN
#undef SC_MERGE
    } else {
        const int sw = w;
        LAS unsigned char* const SP0 = F.lds + MC_SP + (2 * sw) * 4096;
        f32x4 S[2][8], o[2][4];
#pragma unroll
        for (int j = 0; j < 2; ++j)
#pragma unroll
            for (int c = 0; c < 8; ++c) S[j][c] = (f32x4){0.f, 0.f, 0.f, 0.f};
        unsigned trb[2], trx[2];
#pragma unroll
        for (int t = 0; t < 2; ++t) { const unsigned qq_ = l15 >> 2, p_ = lane & 3, X_ = (qq_ << 2) | ((2 * g + t) & 3); trb[t] = 256u * (8 * g + 4 * t + qq_) + 16u * ((p_ >> 1) ^ (X_ & 1)) + 8u * (p_ & 1); trx[t] = X_ >> 1; }
#define TRA(c_, ks_, t_) (trb[t_] + 8192u * (ks_) + (((unsigned)(c_) ^ trx[t_]) << 5))
#define ST_S1(cn_) do { const int pp_ = (cn_) & 1; LAS unsigned char* const QT_ = F.lds + MC_QT + pp_ * 16384; \
        _Pragma("unroll") for (int hf = 0; hf < 2; ++hf) { f32x4 dv[4]; _Pragma("unroll") for (int cc = 0; cc < 4; ++cc) dv[cc] = *(const LAS f32x4*)(s_d + pp_ * 128 + 16 * (4 * hf + cc) + 4 * g); \
            _Pragma("unroll") for (int j = 0; j < 2; ++j) _Pragma("unroll") for (int cc = 0; cc < 4; ++cc) { const int c8 = 4 * hf + cc; S[j][c8] = S[j][c8] * dv[cc]; \
                *(LAS v2u*)(SP0 + j * 4096 + spoff(l15, 2 * c8 + (g >> 1)) + 8 * (g & 1)) = (v2u){cvtpk(S[j][c8][0], S[j][c8][1]), cvtpk(S[j][c8][2], S[j][c8][3])}; } } \
        bf16x8 sa[2][4]; _Pragma("unroll") for (int j = 0; j < 2; ++j) _Pragma("unroll") for (int ks = 0; ks < 4; ++ks) sa[j][ks] = *(const LAS bf16x8*)(SP0 + j * 4096 + spoff(l15, 4 * ks + g)); \
        _Pragma("unroll") for (int nt = 0; nt < 4; ++nt) { bf16x8 qb[4]; _Pragma("unroll") for (int ks = 0; ks < 4; ++ks) qb[ks] = ldrow(QT_, rra16(lane, nt, ks)); \
            f32x4 a0_ = (f32x4){0.f, 0.f, 0.f, 0.f}, a1_ = (f32x4){0.f, 0.f, 0.f, 0.f}; \
            _Pragma("unroll") for (int ks = 0; ks < 4; ++ks) { a0_ = __builtin_amdgcn_mfma_f32_16x16x32_bf16(sa[0][ks], qb[ks], a0_, 0, 0, 0); a1_ = __builtin_amdgcn_mfma_f32_16x16x32_bf16(sa[1][ks], qb[ks], a1_, 0, 0, 0); } \
            o[0][nt] = a0_; o[1][nt] = a1_; } } while (0)
        YA_ENSURE(0);
        __syncthreads();
        SC_SCORES(0, sw); ST_S1(0);
        __syncthreads();
        for (int c = 0; c < NC; ++c) {
            const int pp = c & 1; LAS unsigned char* const KT = F.lds + MC_KT + pp * 16384;
            asm volatile("" : "+v"(trx[0]), "+v"(trx[1]));
            bf16x8 ivf[2][2];
#pragma unroll
            for (int j = 0; j < 2; ++j)
#pragma unroll
                for (int ks = 0; ks < 2; ++ks) ivf[j][ks] = ldtr(IVI, TRA(2 * sw + j, ks, 0), TRA(2 * sw + j, ks, 1));
#pragma unroll
            for (int nt = 0; nt < 4; ++nt) { bf16x8 pb[2];
#pragma unroll
                for (int ks = 0; ks < 2; ++ks) if (2 * ks <= nt) pb[ks] = *(const LAS bf16x8*)(PB + poff(16 * nt + l15, 4 * ks + g));
#pragma unroll
                for (int ks = 0; ks < 2; ++ks) if (2 * ks <= nt) { o[0][nt] = __builtin_amdgcn_mfma_f32_16x16x32_bf16(ivf[0][ks], pb[ks], o[0][nt], 0, 0, 0); o[1][nt] = __builtin_amdgcn_mfma_f32_16x16x32_bf16(ivf[1][ks], pb[ks], o[1][nt], 0, 0, 0); } }
#pragma unroll
            for (int cc = 0; cc < 8; ++cc) { bf16x8 ka[2];
#pragma unroll
                for (int ks = 0; ks < 2; ++ks) ka[ks] = ldtr(KT, TRA(cc, ks, 0), TRA(cc, ks, 1));
#pragma unroll
                for (int ks = 0; ks < 2; ++ks)
#pragma unroll
                    for (int j = 0; j < 2; ++j) S[j][cc] = __builtin_amdgcn_mfma_f32_16x16x32_bf16(ka[ks], ivf[j][ks], S[j][cc], 0, 0, 0); }
#pragma unroll
            for (int nt = 0; nt < 4; ++nt) { float qs = 0.f;
#pragma unroll
                for (int j = 0; j < 2; ++j) { qs += (o[j][nt][0] * o[j][nt][0] + o[j][nt][1] * o[j][nt][1]) + (o[j][nt][2] * o[j][nt][2] + o[j][nt][3] * o[j][nt][3]);
                    *(LAS v2u*)(OB + zvoff(16 * nt + l15, 4 * sw + 2 * j + (g >> 1)) + 8 * (g & 1)) = (v2u){cvtpk(o[j][nt][0], o[j][nt][1]), cvtpk(o[j][nt][2], o[j][nt][3])}; }
                qs += __shfl_xor(qs, 16); qs += __shfl_xor(qs, 32); if (g == 0) s_sq[(16 * nt + l15) * 4 + sw] = qs; }
            __syncthreads();
            YA_ISSUE(min(c + 2, NC - 1));
            if (c + 1 < NC) { SC_SCORES((c + 1) & 1, sw); ST_S1(c + 1); }
            YA_FINISH(min(c + 2, NC - 1));
            __syncthreads();
        }
#undef ST_S1
#undef YA_ENSURE
#undef YA_ISSUE
#undef YA_FINISH
#undef SC_SCORES
#undef TRA
    }
}

typedef int v2i __attribute__((ext_vector_type(2)));
typedef float v2f __attribute__((ext_vector_type(2)));
__device__ __forceinline__ void phase_final(Frame& F) {
    const KArgs* ap_ = kargs(); const KArgs& a = *ap_; unsigned char* ws = a.ws;
    const float* ada = (const float*)(ws + WS_ADA); const float* gp = a.in[I_GPOSTFFN];
    const int* POS = (const int*)(ws + WS_RANK); const int* EID = (const int*)(ws + WS_EID); const LAS int* s_offs = (const LAS int*)(F.lds + 131072 + 512); const float* EW = (const float*)(ws + WS_EW); const bf16* OUTP = (const bf16*)(ws + WS_OUTP); const bf16* X1B = (const bf16*)(ws + WS_X1);
    const int rows_per = T / F.G, row0 = (int)blockIdx.x * rows_per;
    constexpr int R = 2;
    f32x4 ggt[4];
    { const float* ab = ada + (size_t)(row0 / SEQ) * 6144;
#pragma unroll
      for (int j = 0; j < 4; ++j) { const int c = 256 * j + 4 * F.lane; ggt[j] = *(const f32x4*)(gp + c) * *(const f32x4*)(ab + 5 * D + c); } }
    v2i pp[R], ee[R]; v2f ww[R], cw[R]; v2u u0[R][4], u1[R][4], xb[R][4];
#define FN_POS(i0_) do { _Pragma("unroll") for (int r = 0; r < R; ++r) { const int m = row0 + (i0_) + r * NWAVES; pp[r] = *(const v2i*)(POS + 2 * m); ee[r] = *(const v2i*)(EID + 2 * m); ww[r] = *(const v2f*)(EW + 2 * m); } asm volatile("" ::: "memory"); } while (0)
#define FN_ROWS(i0_) do { _Pragma("unroll") for (int r = 0; r < R; ++r) { const int m = row0 + (i0_) + r * NWAVES; \
            const v2u* r0 = (const v2u*)(OUTP + (size_t)(pp[r].x + s_offs[ee[r].x]) * D) + F.lane; const v2u* r1 = (const v2u*)(OUTP + (size_t)(pp[r].y + s_offs[ee[r].y]) * D) + F.lane; const v2u* xrow = (const v2u*)(X1B + (size_t)m * D) + F.lane; \
            _Pragma("unroll") for (int j = 0; j < 4; ++j) { u0[r][j] = r0[64 * j]; u1[r][j] = r1[64 * j]; xb[r][j] = xrow[64 * j]; } cw[r] = ww[r]; } asm volatile("" ::: "memory"); } while (0)
    const int step = R * NWAVES;
    FN_POS(F.wave); FN_ROWS(F.wave);
    FN_POS((F.wave + step < rows_per) ? F.wave + step : F.wave);
    for (int i0 = F.wave; i0 < rows_per; i0 += step) {
        const int i1 = (i0 + step < rows_per) ? i0 + step : i0, i2 = (i1 + step < rows_per) ? i1 + step : i1;
        f32x4 y[R][4], xo[R][4]; float s[R];
#pragma unroll
        for (int r = 0; r < R; ++r) { float t = 0.f; const float w0 = cw[r].x, w1 = cw[r].y;
#pragma unroll
            for (int j = 0; j < 4; ++j) { const v2u a0 = u0[r][j], a1 = u1[r][j], xx = xb[r][j];
                y[r][j].x = w0 * bf2f(a0.x & 0xffffu) + w1 * bf2f(a1.x & 0xffffu); y[r][j].y = w0 * bf2f(a0.x >> 16) + w1 * bf2f(a1.x >> 16);
                y[r][j].z = w0 * bf2f(a0.y & 0xffffu) + w1 * bf2f(a1.y & 0xffffu); y[r][j].w = w0 * bf2f(a0.y >> 16) + w1 * bf2f(a1.y >> 16);
                xo[r][j] = (f32x4){bf2f(xx.x & 0xffffu), bf2f(xx.x >> 16), bf2f(xx.y & 0xffffu), bf2f(xx.y >> 16)};
                t += (y[r][j].x * y[r][j].x + y[r][j].y * y[r][j].y) + (y[r][j].z * y[r][j].z + y[r][j].w * y[r][j].w); }
            s[r] = t; }
        FN_ROWS(i1);
        FN_POS(i2);
#pragma unroll
        for (int o = 1; o < 64; o <<= 1) {
#pragma unroll
            for (int r = 0; r < R; ++r) s[r] += __shfl_xor(s[r], o); }
#pragma unroll
        for (int r = 0; r < R; ++r) { const int m = row0 + i0 + r * NWAVES;
            const float rr = __builtin_amdgcn_rsqf(s[r] * (1.f / D) + RMS_EPS);
            f32x4* orow = (f32x4*)(a.out + (size_t)m * D) + F.lane;
#pragma unroll
            for (int j = 0; j < 4; ++j) __builtin_nontemporal_store(xo[r][j] + ggt[j] * (y[r][j] * rr), orow + 64 * j); }
    }
#undef FN_POS
#undef FN_ROWS
}

__global__ void __launch_bounds__(NTHREADS, 2) mega(Args args) {
    extern __shared__ __attribute__((aligned(16))) unsigned char lds[];
    Frame F; F.lds = (LAS unsigned char*)lds; F.tid = threadIdx.x; F.lane = F.tid & 63; F.wave = __builtin_amdgcn_readfirstlane(F.tid >> 6);
    F.G = gridDim.x; { const int bx = blockIdx.x; F.vcu = (F.G % 8 == 0) ? (bx % 8) * (F.G / 8) + bx / 8 : bx; }
    volatile LAS unsigned* MISC = (volatile LAS unsigned*)(F.lds + MISC_OFF);
    for (int u = F.tid; u < (LDS_BYTES - 131072) / 4; u += NTHREADS) ((LAS unsigned*)(F.lds + 131072))[u] = 0u;
    __syncthreads();
    XcdBarrier bar = xcd_barrier_post((unsigned*)(args.ws + WS_CTL) + CW_BAR + args.li * XCD_BAR_WORDS, MISC + 8);
    const int lo = args.ph_lo, hi = args.ph_hi;
#define IN(k) (lo <= (k) && (k) < hi)
#define SEAM(k) do { if (IN(k) && IN((k) + 1)) xcd_barrier(bar); } while (0)
#ifndef PROBE_MASK
#define PROBE_MASK 0
#endif
#ifndef PROBE_REPS
#define PROBE_REPS 2
#endif
#define REPS(k) for (int rep_ = 0; rep_ < (((PROBE_MASK >> (k)) & 1) ? PROBE_REPS : 1); ++rep_, (void)((((PROBE_MASK >> (k)) & 1) && rep_ < PROBE_REPS) ? (xcd_barrier(bar), 0) : 0))
    if (IN(PH_PREP)) phase_prep(F);
    if (IN(PH_HNORM)) phase_hnorm(F, IN(PH_PREP)); SEAM(PH_HNORM);
    unsigned char* const ws = args.ws;
    if (IN(PH_INPROJ)) REPS(PH_INPROJ) {
        pg8::Gemm g{(const bf16*)(ws + WS_H), (const bf16*)(ws + WS_WIN), T, NIN, D / 2}; pg8::StaticOrder S; S.init(T, NIN, F.G, (int)blockIdx.x); S.rot4 = 1;
        pg8::EpiInproj8 E{(bf16*)(ws + WS_GAU), (bf16*)(ws + WS_GBOG), (bf16*)(ws + WS_GV), (bf16*)(ws + WS_QS), (bf16*)(ws + WS_G), (bf16*)(ws + WS_IV), (float*)(ws + WS_VSTAT), (const float*)(ws + WS_LBV), (const float*)(ws + WS_HSC), (const float*)(ws + WS_WSC)};
        pg8::gemm_phase<pg8::EpiInproj8, pg8::StaticOrder, true, true, false, true>(F.lds, g, S, E);
    } SEAM(PH_INPROJ);
    if (IN(PH_MIXB)) REPS(PH_MIXB) { phase_mixb(F); } SEAM(PH_MIXB);
    if (IN(PH_OUTPROJ)) REPS(PH_OUTPROJ) {
        pg8::Gemm g{(const bf16*)(ws + WS_H), (const bf16*)(ws + WS_WOUT), T, D, D}; pg8::StaticOrder S; S.init(T, D, F.G, (int)blockIdx.x);
        pg8::EpiBf16 E{(bf16*)(ws + WS_Y2), D};
        pg8::gemm_phase<pg8::EpiBf16, pg8::StaticOrder, true, true>(F.lds, g, S, E);
    } SEAM(PH_OUTPROJ);
    if (IN(PH_ROW1)) REPS(PH_ROW1) { phase_row1(F); } SEAM(PH_ROW1);
    LAS int* s_offs = (LAS int*)(F.lds + 131072 + 512);
    LAS int* s_tot = s_offs + 32;
    if (IN(PH_MOE1) || IN(PH_MOE2) || IN(PH_FINAL)) {
        if (F.tid < NE) s_tot[F.tid] = (int)__hip_atomic_load((unsigned*)(ws + WS_CTL) + CW_TOT + 64 * F.tid, RLX_AGENT);
        __syncthreads();
        if (F.tid == 0) { int o = 0; for (int e = 0; e < NE; ++e) { s_offs[e] = o; o += (s_tot[e] + 255) & ~255; } s_offs[NE] = o; }
        __syncthreads(); }
    unsigned* const pcnt = (unsigned*)(ws + WS_CTL) + CW_PANEL;
    if (IN(PH_MOE1)) {
        pg8::GroupedSignal S; S.init(s_offs, D, F.G, (int)blockIdx.x); S.cnt = pcnt;
        LAS int* s_idx = (LAS int*)(F.lds + 133120);
        { const int* IDXREL = (const int*)(ws + WS_IDXREL);
          int tok[3]; bool have[3];
#pragma unroll
          for (int k = 0; k < 3; ++k) { pg8::Unit u; const int i = 2 * k + (int)(F.tid >> 8); have[k] = S.next(i, u); tok[k] = 0;
              if (have[k]) { const int e = u.pnb / (D / 256), lr = u.pm * 256 - s_offs[e] + (int)(F.tid & 255); if (lr < s_tot[e]) tok[k] = IDXREL[e * 65536 + lr]; } }
#pragma unroll
          for (int k = 0; k < 3; ++k) if (have[k]) s_idx[(2 * k + (int)(F.tid >> 8)) * 256 + (F.tid & 255)] = tok[k];
          __syncthreads(); }
        pg8::Gemm g{(const bf16*)(ws + WS_H2), (const bf16*)(ws + WS_W13), NPMAX, D, D / 2, s_idx};
        pg8::EpiMoe1I8 E{(bf16*)(ws + WS_ACT), NPMAX * FF * 2, (const float*)(ws + WS_SCREL), (const float*)(ws + WS_WSC13), s_offs, s_tot};
        pg8::gemm_phase<pg8::EpiMoe1I8, pg8::GroupedSignal, true, true, true, true>(F.lds, g, S, E);
    }
    if (IN(PH_MOE1) && !IN(PH_MOE2)) xcd_barrier(bar);
    if (IN(PH_MOE2)) {
        pg8::Gemm g{(const bf16*)(ws + WS_ACT), (const bf16*)(ws + WS_W2), NPMAX, D, FF}; pg8::GroupedWait S; S.init(s_offs, D, F.G, F.G - 1 - (int)blockIdx.x); S.cnt = pcnt; S.need = 8u * (D / 256);
        S.qcnt = (unsigned*)(ws + WS_CTL) + CW_QUEUE; S.xcd = (int)(xb_xcc_id() & 7u); S.slot = (LAS int*)(F.lds + 131072 + 128);
        pg8::EpiBf16 E{(bf16*)(ws + WS_OUTP), D};
        pg8::gemm_phase<pg8::EpiBf16, pg8::GroupedWait, true, true>(F.lds, g, S, E);
    } SEAM(PH_MOE2);
    if (IN(PH_FINAL)) { phase_final(F); }
#undef IN
#undef SEAM
}

template <class Epi, bool PAIRED>
__global__ void __launch_bounds__(256) naive_gemm(const bf16* __restrict__ A, const bf16* __restrict__ Bt, int K, int ntn, const int* __restrict__ offs, size_t estride, Epi E) {
    __shared__ __attribute__((aligned(16))) bf16 sA[64 * 40], sB0[64 * 40], sB1[64 * 40];
    const int bx = blockIdx.x % ntn, by = blockIdx.x / ntn, m0 = by * 64;
    const bf16* Bb = Bt;
    if (offs) { if (m0 >= offs[NE]) return; int e = 0; while (m0 >= offs[e + 1]) ++e; Bb += (size_t)e * estride; }
    int n0a, n0b = 0, pn = 0, cc0 = 0;
    if (PAIRED) { pn = bx >> 1; cc0 = (bx & 1) * 64; n0a = 256 * pn + cc0; n0b = n0a + 128; } else n0a = bx * 64;
    const int tid = threadIdx.x, lane = tid & 63, w = tid >> 6, lr = tid >> 2, lc = (tid & 3) * 8;
    f32x4 acc0[4], acc1[4];
#pragma unroll
    for (int n = 0; n < 4; ++n) { acc0[n] = (f32x4){0.f, 0.f, 0.f, 0.f}; acc1[n] = (f32x4){0.f, 0.f, 0.f, 0.f}; }
    for (int k0 = 0; k0 < K; k0 += 32) {
        *(v4u*)&sA[lr * 40 + lc] = *(const v4u*)&A[(size_t)(m0 + lr) * K + k0 + lc];
        *(v4u*)&sB0[lr * 40 + lc] = *(const v4u*)&Bb[(size_t)(n0a + lr) * K + k0 + lc];
        if (PAIRED) *(v4u*)&sB1[lr * 40 + lc] = *(const v4u*)&Bb[(size_t)(n0b + lr) * K + k0 + lc];
        __syncthreads();
        const bf16x8 av = *(const bf16x8*)&sA[(16 * w + (lane & 15)) * 40 + 8 * (lane >> 4)];
#pragma unroll
        for (int n = 0; n < 4; ++n) {
            const bf16x8 b0 = *(const bf16x8*)&sB0[(16 * n + (lane & 15)) * 40 + 8 * (lane >> 4)];
            acc0[n] = __builtin_amdgcn_mfma_f32_16x16x32_bf16(av, b0, acc0[n], 0, 0, 0);
            if (PAIRED) { const bf16x8 b1 = *(const bf16x8*)&sB1[(16 * n + (lane & 15)) * 40 + 8 * (lane >> 4)];
                acc1[n] = __builtin_amdgcn_mfma_f32_16x16x32_bf16(av, b1, acc1[n], 0, 0, 0); }
        }
        __syncthreads();
    }
#pragma unroll
    for (int n = 0; n < 4; ++n)
#pragma unroll
        for (int r = 0; r < 4; ++r) { const int row = m0 + 16 * w + 4 * (lane >> 4) + r, cin = 16 * n + (lane & 15);
            if (PAIRED) E.pair(row, pn, cc0 + cin, acc0[n][r], acc1[n][r]); else E.one(row, n0a + cin, acc0[n][r]); }
}
struct EpiInprojN { bf16 *GAU, *GBOG, *GV, *QS, *G, *IV; const float* lbv;
    __device__ __forceinline__ void pair(int row, int pn, int cc, float v0, float v1) const {
        const int j = pn >> 2, type = pn & 3, col = 128 * j + cc; const size_t idx = (size_t)row * D + col;
        if (type == 0) GAU[idx] = (bf16)f2bf(gelu_f(v0) * sigmoid_f(v1));
        else if (type == 1) GBOG[idx] = (bf16)f2bf(silu_f(v0) * sigmoid_f(v1));
        else if (type == 2) { GV[idx] = (bf16)f2bf(gelu_f(v0)); QS[idx] = (bf16)f2bf(silu_f(v1)); }
        else { const float lb = lbv[col]; G[idx] = (bf16)f2bf(logf(lb + (1.0f - lb) * sigmoid_f(v0))); IV[idx] = (bf16)f2bf(v1); }
    }
    __device__ __forceinline__ void one(int, int, float) const {}
};
struct EpiF32N { float* C; __device__ __forceinline__ void one(int row, int col, float v) const { C[(size_t)row * D + col] = v; } __device__ __forceinline__ void pair(int, int, int, float, float) const {} };
struct EpiMoe1N { bf16* ACT; __device__ __forceinline__ void pair(int row, int pn, int cc, float v0, float v1) const { ACT[(size_t)row * FF + 128 * pn + cc] = (bf16)f2bf(silu_f(v0) * v1); } __device__ __forceinline__ void one(int, int, float) const {} };
struct EpiBf16N { bf16* C; __device__ __forceinline__ void one(int row, int col, float v) const { C[(size_t)row * D + col] = (bf16)f2bf(v); } __device__ __forceinline__ void pair(int, int, int, float, float) const {} };

__global__ void __launch_bounds__(256) naive_vstat(const bf16* __restrict__ GV, float* __restrict__ VSTAT) {
    const int row = blockIdx.x * 4 + (threadIdx.x >> 6), lane = threadIdx.x & 63;
    float s = 0.f, ss = 0.f;
    for (int c = lane; c < D; c += 64) { const float v = bf2f(GV[(size_t)row * D + c]); s += v; ss += v * v; }
    s = wave_sum(s); ss = wave_sum(ss);
    if (lane < 32) { float* p = VSTAT + ((size_t)row * 32 + lane) * 2; p[0] = lane == 0 ? s : 0.f; p[1] = lane == 0 ? ss : 0.f; }
}

__global__ void __launch_bounds__(256) naive_mixer(Args a) {
    extern __shared__ __attribute__((aligned(16))) unsigned char lds[];
    float* s_vn = (float*)lds;
    float* s_zv = s_vn + 128 * 128;
    float* s_f = s_zv + 128 * 128;
    float* s_op = s_f + 384;
    float* s_red = s_op + 256;
    float* s_mu = s_red + 4;
    unsigned char* ws = a.ws;
    const bf16 *GAU = (const bf16*)(ws + WS_GAU), *GBOG = (const bf16*)(ws + WS_GBOG), *GV = (const bf16*)(ws + WS_GV), *QS = (const bf16*)(ws + WS_QS), *G = (const bf16*)(ws + WS_G), *IV = (const bf16*)(ws + WS_IV);
    const float* VSTAT = (const float*)(ws + WS_VSTAT); bf16* Y = (bf16*)(ws + WS_H);
    const int b = blockIdx.x >> 3, h = blockIdx.x & 7, tid = threadIdx.x, v = tid & 127, kh = tid >> 7, ch = 128 * h + v;
    const float* Wsp = a.in[I_WSP] + (size_t)h * 128 * 128; const float* bsp = a.in[I_BSP] + h * 128;
    const float lng = a.in[I_LNVG][ch], lnb = a.in[I_LNVB][ch], ghg = a.in[I_GHGRN][ch];
    float S[64];
#pragma unroll
    for (int i = 0; i < 64; ++i) S[i] = 0.f;
    for (int n = 0; n < SEQ / 128; ++n) {
        const size_t t0 = (size_t)b * SEQ + 128 * n;
        __syncthreads();
        if (tid < 128) { const float* p = VSTAT + (t0 + tid) * 64; float s = 0.f, ss = 0.f; for (int q = 0; q < 32; ++q) { s += p[2 * q]; ss += p[2 * q + 1]; }
            const float mu = s * (1.f / D), var = ss * (1.f / D) - mu * mu; s_mu[tid] = mu; s_mu[128 + tid] = 1.0f / sqrtf(var + LN_EPS); }
        __syncthreads();
        for (int s = kh; s < 128; s += 2) s_vn[s * 128 + v] = (bf2f(GV[(t0 + s) * D + ch]) - s_mu[s]) * s_mu[128 + s] * lng + lnb;
        __syncthreads();
        for (int t = kh; t < 128; t += 2) { float acc = bsp[t]; const float* wr = Wsp + t * 128;
            for (int s = 0; s <= t; ++s) acc += wr[s] * s_vn[s * 128 + v];
            s_zv[t * 128 + v] = acc; }
        __syncthreads();
        for (int tok = 0; tok < 128; ++tok) {
            const size_t tg = t0 + tok;
            if (tid < 128) { const float f = __expf(bf2f(G[tg * D + ch])); s_f[tid] = f; s_f[128 + tid] = 1.0f - f; s_f[256 + tid] = bf2f(QS[tg * D + ch]); }
            __syncthreads();
            const float iv = bf2f(IV[tg * D + ch]); float part = 0.f;
#pragma unroll
            for (int i = 0; i < 64; ++i) { const int k = 64 * kh + i; S[i] = s_f[k] * S[i] + s_f[128 + k] * iv; part += s_f[256 + k] * S[i]; }
            s_op[kh * 128 + v] = part;
            __syncthreads();
            float o = 0.f;
            if (tid < 128) { o = s_op[v] + s_op[128 + v]; const float sq = wave_sum(o * o); if ((tid & 63) == 0) s_red[tid >> 6] = sq; }
            __syncthreads();
            if (tid < 128) { const float rstd = 1.0f / sqrtf((s_red[0] + s_red[1]) * (1.f / 128.f) + RMS_EPS);
                const float y = bf2f(GAU[tg * D + ch]) * s_zv[tok * 128 + v] + bf2f(GBOG[tg * D + ch]) * (o * rstd * ghg);
                Y[tg * D + ch] = (bf16)f2bf(y); }
        }
    }
}

extern "C" void kernel_launch(void* const* d_in, const int* in_sizes, int n_in, void* d_out, int out_size, void* d_ws, size_t ws_size, hipStream_t stream) {
    static int grid = 0;
    if (grid == 0) {
        if (n_in != 23 || in_sizes[0] != T * D || out_size != T * D || ws_size < WS_END) { fprintf(stderr, "kernel_launch: unexpected shapes / workspace (n_in %d, in0 %d, out %d, ws %zu)\n", n_in, n_in > 0 ? in_sizes[0] : -1, out_size, ws_size); grid = -1; return; }
        int dev = 0, cus = 0;
        if (hipGetDevice(&dev) != hipSuccess || hipDeviceGetAttribute(&cus, hipDeviceAttributeMultiprocessorCount, dev) != hipSuccess) { grid = -1; return; }
        if (hipFuncSetAttribute((const void*)mega, hipFuncAttributeMaxDynamicSharedMemorySize, LDS_BYTES) != hipSuccess) { fprintf(stderr, "kernel_launch: hipFuncSetAttribute(mega) failed\n"); grid = -1; return; }
        if (hipFuncSetAttribute((const void*)naive_mixer, hipFuncAttributeMaxDynamicSharedMemorySize, 140000) != hipSuccess) { fprintf(stderr, "kernel_launch: hipFuncSetAttribute(naive_mixer) failed\n"); grid = -1; return; }
        (void)hipGetLastError();
        grid = cus;
        if (grid != 256) fprintf(stderr, "kernel_launch: %d CUs (built for 256)\n", grid);
    }
    if (grid < 0) return;
    (void)hipMemsetAsync((char*)d_ws + WS_CTL, 0, CTL_ZERO_BYTES, stream);
    Args a{};
    for (int i = 0; i < 23; ++i) a.in[i] = (const float*)d_in[i];
    a.out = (float*)d_out; a.ws = (unsigned char*)d_ws;
    unsigned char* ws = (unsigned char*)d_ws;
    int li = 0;
    auto run = [&](int lo, int hi) { a.ph_lo = lo; a.ph_hi = hi; a.li = li++; hipLaunchKernelGGL(mega, dim3(grid), dim3(NTHREADS), LDS_BYTES, stream, a); };
    run(PH_PREP, PH_N);
}
```
